# Optimizing an MI355X kernel written in HIP

```python
import math
import jax, jax.numpy as jnp
from jax import lax
import numpy as np

D_MODEL = 1024
BATCH = 2
SEQ = 8192
DEPTH = 1

RWKV_HEAD = 64
D_RWKV = D_MODEL // 2
N_RWKV_HEADS = D_RWKV // RWKV_HEAD
DECAY_LORA = 64
AAA_LORA = 64
GATE_LORA = 160
LN_X_EPS = 64e-5
D_CONV = D_MODEL // 2
CONV_WIDTH = 3
N_MEM = 256
N_XHEADS = 4
XHEAD_DIM = D_MODEL // N_XHEADS
D_FF = 4 * D_MODEL
RMS_EPS = 1e-6

SPLITS = (D_RWKV, D_RWKV, D_RWKV, DECAY_LORA, AAA_LORA, GATE_LORA,
          D_CONV, D_CONV, D_CONV,
          D_MODEL, D_MODEL)
D_IN = sum(SPLITS)
RWKV_COLS = 3 * D_RWKV + DECAY_LORA + AAA_LORA + GATE_LORA

kernel_name = "hybrid_rwkv7_shortconv_xattn_block"


def rms_norm(x, g):
    xf = x.astype(jnp.float32)
    y = xf * lax.rsqrt(jnp.mean(xf * xf, axis=-1, keepdims=True) + RMS_EPS)
    return (y * g.astype(jnp.float32)).astype(x.dtype)


def token_shift(p):
    return jnp.pad(p[:, :-1], ((0, 0), (1, 0), (0, 0)))


def wkv7_scan(r, w, k, v, a, b):
    bsz, _, h, n = r.shape

    def step(state, inp):
        r_t, w_t, k_t, v_t, a_t, b_t = inp
        sa = jnp.einsum("bhvk,bhk->bhv", state, a_t)
        state = (state * w_t[:, :, None, :]
                 + sa[..., None] * b_t[:, :, None, :]
                 + v_t[..., None] * k_t[:, :, None, :])
        return state, jnp.einsum("bhvk,bhk->bhv", state, r_t)

    xs = tuple(jnp.moveaxis(t, 1, 0) for t in (r, w, k, v, a, b))
    s0 = jnp.zeros((bsz, h, n, n), jnp.float32)
    _, ys = lax.scan(step, s0, xs)
    return jnp.moveaxis(ys, 0, 1)


def rwkv7_branch(r, k, v, wd, ad, gd, w0, w_lora_w, a0, w_lora_a, w_lora_g,
                 k_k, k_a, r_k, ln_x_w, ln_x_b):
    bsz, s, _ = r.shape
    f32 = jnp.float32
    log_w = -jax.nn.softplus(-(w0 + jnp.tanh(wd) @ w_lora_w)) - 0.5
    decay = jnp.exp(-jnp.exp(log_w.astype(f32)))
    a = jax.nn.sigmoid(a0 + ad @ w_lora_a)
    g = jax.nn.sigmoid(gd) @ w_lora_g

    def heads(t):
        return t.reshape(bsz, s, N_RWKV_HEADS, RWKV_HEAD).astype(f32)

    kk = heads(k * k_k)
    kk = kk / jnp.maximum(jnp.sqrt(jnp.sum(kk * kk, axis=-1, keepdims=True)), 1e-12)
    k = k * (1.0 + (a - 1.0) * k_a)
    rh, kh, vh, ah, wh = heads(r), heads(k), heads(v), heads(a), heads(decay)
    y = wkv7_scan(rh, wh, kh, vh, -kk, kk * ah)
    mu = jnp.mean(y, axis=-1, keepdims=True)
    var = jnp.mean(jnp.square(y - mu), axis=-1, keepdims=True)
    y = (y - mu) * lax.rsqrt(var + LN_X_EPS)
    y = y.reshape(bsz, s, D_RWKV) * ln_x_w.astype(f32) + ln_x_b.astype(f32)
    bonus = jnp.sum(rh * kh * r_k.astype(f32), axis=-1, keepdims=True) * vh
    y = y + bonus.reshape(bsz, s, D_RWKV)
    return y.astype(r.dtype) * g


def short_conv_branch(bg, cg, xc, conv_w):
    u = cg * xc
    y = lax.conv_general_dilated(
        u, conv_w.astype(u.dtype), window_strides=(1,),
        padding=[(CONV_WIDTH - 1, 0)],
        dimension_numbers=("NWC", "WIO", "NWC"),
        feature_group_count=D_CONV)
    return bg * y


def memory_cross_attention(h, mem_n, w_q, w_kv, w_xo):
    bsz, s, _ = h.shape
    n_mem = mem_n.shape[1]
    q = (h @ w_q).reshape(bsz, s, N_XHEADS, XHEAD_DIM)
    k, v = jnp.split(mem_n @ w_kv, 2, axis=-1)
    k = k.reshape(bsz, n_mem, N_XHEADS, XHEAD_DIM)
    v = v.reshape(bsz, n_mem, N_XHEADS, XHEAD_DIM)
    scores = jnp.einsum("bshd,bmhd->bhsm", q, k).astype(jnp.float32) / math.sqrt(XHEAD_DIM)
    probs = jax.nn.softmax(scores, axis=-1).astype(v.dtype)
    o = jnp.einsum("bhsm,bmhd->bshd", probs, v).reshape(bsz, s, D_MODEL)
    return o @ w_xo


def setup_inputs(seed: int = 0) -> dict:
    key = jax.random.key(seed)
    ks = jax.random.split(key, 32)
    it = iter(range(32))
    f32 = jnp.float32
    L = DEPTH

    def nrm(shape, scale):
        return scale * jax.random.normal(ks[next(it)], shape, f32)

    def gain(shape):
        return 1.0 + 0.05 * jax.random.normal(ks[next(it)], shape, f32)

    return {
        "x": nrm((BATCH, SEQ, D_MODEL), 1.0),
        "mem": nrm((BATCH, N_MEM, D_MODEL), 1.0),
        "norm_mix": gain((L, D_MODEL)),
        "w_in": nrm((L, D_MODEL, D_IN), D_MODEL ** -0.5),
        "b_gate": nrm((L, 2 * D_MODEL), 0.01),
        "mu_shift": jax.random.uniform(ks[next(it)], (L, RWKV_COLS), f32),
        "w0": jax.random.uniform(ks[next(it)], (L, D_RWKV), f32, -6.0, -1.0),
        "w_lora_w": nrm((L, DECAY_LORA, D_RWKV), 0.1 * DECAY_LORA ** -0.5),
        "a0": nrm((L, D_RWKV), 0.1),
        "w_lora_a": nrm((L, AAA_LORA, D_RWKV), AAA_LORA ** -0.5),
        "w_lora_g": nrm((L, GATE_LORA, D_RWKV), GATE_LORA ** -0.5),
        "k_k": 0.85 + nrm((L, D_RWKV), 0.05),
        "k_a": gain((L, D_RWKV)),
        "r_k": nrm((L, N_RWKV_HEADS, RWKV_HEAD), 0.1),
        "ln_x_w": gain((L, D_RWKV)),
        "ln_x_b": nrm((L, D_RWKV), 0.01),
        "conv_w": nrm((L, CONV_WIDTH, 1, D_CONV), CONV_WIDTH ** -0.5),
        "w_proj_a": nrm((L, D_RWKV, D_MODEL), D_RWKV ** -0.5),
        "w_proj_b": nrm((L, D_CONV, D_MODEL), D_CONV ** -0.5),
        "w_out_mix": nrm((L, D_MODEL, D_MODEL), D_MODEL ** -0.5),
        "norm_xattn": gain((L, D_MODEL)),
        "norm_mem": gain((L, D_MODEL)),
        "w_q": nrm((L, D_MODEL, D_MODEL), D_MODEL ** -0.5),
        "w_kv": nrm((L, D_MODEL, 2 * D_MODEL), D_MODEL ** -0.5),
        "w_xo": nrm((L, D_MODEL, D_MODEL), D_MODEL ** -0.5),
        "norm_mlp": gain((L, D_MODEL)),
        "w_up": nrm((L, D_MODEL, D_FF), D_MODEL ** -0.5),
        "w_down": nrm((L, D_FF, D_MODEL), D_FF ** -0.5),
        "norm_final": gain((D_MODEL,)),
    }


def reference(x, mem, norm_mix, w_in, b_gate, mu_shift, w0, w_lora_w, a0, w_lora_a,
              w_lora_g, k_k, k_a, r_k, ln_x_w, ln_x_b, conv_w, w_proj_a, w_proj_b,
              w_out_mix, norm_xattn, norm_mem, w_q, w_kv, w_xo, norm_mlp, w_up,
              w_down, norm_final):
    offsets = np.cumsum(SPLITS)[:-1].tolist()
    for i in range(DEPTH):
        h = rms_norm(x, norm_mix[i])
        p = h @ w_in[i]
        p_rw = p[..., :RWKV_COLS]
        p_rw = p_rw + (token_shift(p_rw) - p_rw) * mu_shift[i]
        p = jnp.concatenate([p_rw, p[..., RWKV_COLS:]], axis=-1)
        r, k, v, wd, ad, gd, cb, cc, cx, ga, gb = jnp.split(p, offsets, axis=-1)
        out_a = rwkv7_branch(r, k, v, wd, ad, gd, w0[i], w_lora_w[i], a0[i], w_lora_a[i],
                             w_lora_g[i], k_k[i], k_a[i], r_k[i], ln_x_w[i], ln_x_b[i])
        out_b = short_conv_branch(cb, cc, cx, conv_w[i])
        bg_a, bg_b = jnp.split(b_gate[i], 2)
        merged = (jax.nn.sigmoid(ga + bg_a) * (out_a @ w_proj_a[i])
                  + jax.nn.sigmoid(gb + bg_b) * (out_b @ w_proj_b[i]))
        x = x + merged @ w_out_mix[i]
        mem_n = rms_norm(mem, norm_mem[i])
        x = x + memory_cross_attention(rms_norm(x, norm_xattn[i]), mem_n,
                                       w_q[i], w_kv[i], w_xo[i])
        hm = rms_norm(x, norm_mlp[i])
        x = x + jnp.square(jax.nn.relu(hm @ w_up[i])) @ w_down[i]
    return rms_norm(x, norm_final)
```

```cpp
#include <hip/hip_runtime.h>
#include <cstdint>
#include <cstdio>

constexpr int NB = 2, SEQ = 8192, DM = 1024, T = NB * SEQ;
constexpr int DR = 512, NH = 8, HD = 64, RWC = 1824, DIN = 5408;
constexpr int NMEM = 256, XH = 4, XD = 256, DFF = 4096;
constexpr float RMS_EPS = 1e-6f, LN_X_EPS = 64e-5f;

__device__ __forceinline__ float wave_sum(float v) {
#pragma unroll
    for (int o = 1; o < 64; o <<= 1) v += __shfl_xor(v, o);
    return v;
}
__device__ __forceinline__ float sigmoidf_(float x) { return 1.f / (1.f + __expf(-x)); }

__global__ __launch_bounds__(256) void rmsnorm_k(const float* __restrict__ x, const float* __restrict__ g, float* __restrict__ out, int rows) {
    const int row = blockIdx.x * 4 + (threadIdx.x >> 6), lane = threadIdx.x & 63;
    if (row >= rows) return;
    const float4* xr = (const float4*)(x + (size_t)row * DM);
    float4 v[4]; float s = 0.f;
#pragma unroll
    for (int j = 0; j < 4; ++j) { v[j] = xr[lane + 64 * j]; s += v[j].x * v[j].x + v[j].y * v[j].y + v[j].z * v[j].z + v[j].w * v[j].w; }
    const float r = rsqrtf(wave_sum(s) * (1.f / DM) + RMS_EPS);
    float4* o = (float4*)(out + (size_t)row * DM);
#pragma unroll
    for (int j = 0; j < 4; ++j) { const float4 gg = ((const float4*)g)[lane + 64 * j]; float4 w; w.x = v[j].x * r * gg.x; w.y = v[j].y * r * gg.y; w.z = v[j].z * r * gg.z; w.w = v[j].w * r * gg.w; o[lane + 64 * j] = w; }
}

enum { EPI_STORE = 0, EPI_RESID = 1, EPI_SIGGATE = 2, EPI_RELU2 = 3 };
template <int EPI>
__global__ __launch_bounds__(256) void gemm_f32(const float* __restrict__ A, int lda, const float* __restrict__ Bm, int ldb, float* C, int ldc,
                                                int M, int N, int K, const float* R, int ldr, const float* __restrict__ bias) {
    __shared__ float As[16][68];
    __shared__ float Bs[16][68];
    const int tid = threadIdx.x, tx = tid & 15, ty = tid >> 4;
    const int m0 = blockIdx.y * 64, n0 = blockIdx.x * 64;
    float acc[4][4];
#pragma unroll
    for (int i = 0; i < 4; ++i)
#pragma unroll
        for (int j = 0; j < 4; ++j) acc[i][j] = 0.f;
    const int ar = tid >> 2, ak = (tid & 3) * 4;
    const int bk = tid >> 4, bc = (tid & 15) * 4;
    for (int k0 = 0; k0 < K; k0 += 16) {
        const float4 av = *(const float4*)(A + (size_t)(m0 + ar) * lda + k0 + ak);
        float4 bv = make_float4(0.f, 0.f, 0.f, 0.f);
        if (n0 + bc < N) bv = *(const float4*)(Bm + (size_t)(k0 + bk) * ldb + n0 + bc);
        __syncthreads();
        As[ak + 0][ar] = av.x; As[ak + 1][ar] = av.y; As[ak + 2][ar] = av.z; As[ak + 3][ar] = av.w;
        *(float4*)&Bs[bk][bc] = bv;
        __syncthreads();
#pragma unroll
        for (int kk = 0; kk < 16; ++kk) {
            const float4 a4 = *(const float4*)&As[kk][ty * 4];
            const float4 b4 = *(const float4*)&Bs[kk][tx * 4];
            const float a[4] = {a4.x, a4.y, a4.z, a4.w}, b[4] = {b4.x, b4.y, b4.z, b4.w};
#pragma unroll
            for (int i = 0; i < 4; ++i)
#pragma unroll
                for (int j = 0; j < 4; ++j) acc[i][j] = fmaf(a[i], b[j], acc[i][j]);
        }
    }
    const int col = n0 + tx * 4;
    if (col >= N) return;
#pragma unroll
    for (int i = 0; i < 4; ++i) {
        const int row = m0 + ty * 4 + i;
        float4 o = make_float4(acc[i][0], acc[i][1], acc[i][2], acc[i][3]);
        float* cp = C + (size_t)row * ldc + col;
        if (EPI == EPI_RESID) { const float4 r = *(const float4*)(R + (size_t)row * ldr + col); o.x += r.x; o.y += r.y; o.z += r.z; o.w += r.w; }
        if (EPI == EPI_SIGGATE) {
            const float4 g = *(const float4*)cp; const float4 bb = *(const float4*)(bias + col);
            o.x *= sigmoidf_(g.x + bb.x); o.y *= sigmoidf_(g.y + bb.y); o.z *= sigmoidf_(g.z + bb.z); o.w *= sigmoidf_(g.w + bb.w);
            if (R) { const float4 r = *(const float4*)(R + (size_t)row * ldr + col); o.x += r.x; o.y += r.y; o.z += r.z; o.w += r.w; }
        }
        if (EPI == EPI_RELU2) { o.x = fmaxf(o.x, 0.f); o.x *= o.x; o.y = fmaxf(o.y, 0.f); o.y *= o.y; o.z = fmaxf(o.z, 0.f); o.z *= o.z; o.w = fmaxf(o.w, 0.f); o.w *= o.w; }
        *(float4*)cp = o;
    }
}
template <int EPI>
static void gemm(hipStream_t st, const float* A, int lda, const float* Bm, int ldb, float* C, int ldc, int M, int N, int K, const float* R = nullptr, int ldr = 0, const float* bias = nullptr) {
    dim3 grid((N + 63) / 64, M / 64);
    hipLaunchKernelGGL(gemm_f32<EPI>, grid, dim3(256), 0, st, A, lda, Bm, ldb, C, ldc, M, N, K, R, ldr, bias);
}

__device__ __forceinline__ float shiftmix(const float* __restrict__ prw, const float* __restrict__ mu, int t, int c) {
    const float p = prw[(size_t)t * RWC + c];
    const float prev = (t % SEQ == 0) ? 0.f : prw[(size_t)(t - 1) * RWC + c];
    return p + (prev - p) * mu[c];
}

__global__ __launch_bounds__(256) void lora_in_k(const float* __restrict__ prw, const float* __restrict__ mu, float* __restrict__ twd, float* __restrict__ ad, float* __restrict__ sgd) {
    const size_t idx = (size_t)blockIdx.x * 256 + threadIdx.x;
    if (idx >= (size_t)T * 288) return;
    const int t = (int)(idx / 288), c = (int)(idx % 288);
    const float v = shiftmix(prw, mu, t, 1536 + c);
    if (c < 64) twd[(size_t)t * 64 + c] = tanhf(v);
    else if (c < 128) ad[(size_t)t * 64 + (c - 64)] = v;
    else sgd[(size_t)t * 160 + (c - 128)] = sigmoidf_(v);
}

__global__ __launch_bounds__(256) void wkv_scan_k(const float* __restrict__ prw, const float* __restrict__ mu, float* lwp_y  ,
                                                  const float* __restrict__ apre, const float* __restrict__ w0, const float* __restrict__ a0,
                                                  const float* __restrict__ k_k, const float* __restrict__ k_a, const float* __restrict__ r_k, float* __restrict__ bonus) {
    constexpr int G = 16;
    __shared__ float sr[G][64], sw[G][64], sk[G][64], sa[G][64], sb[G][64], sv[G][64];
    const int b = blockIdx.x / NH, h = blockIdx.x % NH, tid = threadIdx.x;
    const int row = tid >> 2, part = tid & 3;
    float S[16];
#pragma unroll
    for (int j = 0; j < 16; ++j) S[j] = 0.f;
    const int st_t = tid >> 4, st_j = (tid & 15) * 4;
    for (int g0 = 0; g0 < SEQ; g0 += G) {
        __syncthreads();
        {
            const int t = b * SEQ + g0 + st_t;
            float nrm = 0.f, bon = 0.f; float kkv[4], alr[4];
#pragma unroll
            for (int e = 0; e < 4; ++e) {
                const int j = st_j + e, col = h * HD + j;
                const float rr = shiftmix(prw, mu, t, col), kraw = shiftmix(prw, mu, t, 512 + col), vv = shiftmix(prw, mu, t, 1024 + col);
                const float xw = w0[col] + lwp_y[(size_t)t * DR + col];
                const float z = -xw; const float sp = fmaxf(z, 0.f) + log1pf(__expf(-fabsf(z)));
                const float logw = -sp - 0.5f;
                const float decay = __expf(-__expf(logw));
                alr[e] = sigmoidf_(a0[col] + apre[(size_t)t * DR + col]);
                kkv[e] = kraw * k_k[col]; nrm += kkv[e] * kkv[e];
                const float kmod = kraw * (1.f + (alr[e] - 1.f) * k_a[col]);
                bon += rr * kmod * r_k[col];
                sr[st_t][j] = rr; sw[st_t][j] = decay; sk[st_t][j] = kmod; sv[st_t][j] = vv;
            }
#pragma unroll
            for (int o = 1; o < 16; o <<= 1) { nrm += __shfl_xor(nrm, o); bon += __shfl_xor(bon, o); }
            const float inv = 1.f / fmaxf(sqrtf(nrm), 1e-12f);
#pragma unroll
            for (int e = 0; e < 4; ++e) { const float kn = kkv[e] * inv; sa[st_t][st_j + e] = -kn; sb[st_t][st_j + e] = kn * alr[e]; }
            if ((tid & 15) == 0) bonus[(size_t)t * NH + h] = bon;
        }
        __syncthreads();
#pragma unroll 1
        for (int tt = 0; tt < G; ++tt) {
            float dot = 0.f;
#pragma unroll
            for (int j = 0; j < 16; ++j) dot = fmaf(S[j], sa[tt][part * 16 + j], dot);
            dot += __shfl_xor(dot, 1); dot += __shfl_xor(dot, 2);
            const float vv = sv[tt][row];
            float y = 0.f;
#pragma unroll
            for (int j = 0; j < 16; ++j) {
                const int kx = part * 16 + j;
                S[j] = fmaf(S[j], sw[tt][kx], fmaf(dot, sb[tt][kx], vv * sk[tt][kx]));
                y = fmaf(S[j], sr[tt][kx], y);
            }
            y += __shfl_xor(y, 1); y += __shfl_xor(y, 2);
            if (part == 0) lwp_y[(size_t)(b * SEQ + g0 + tt) * DR + h * HD + row] = y;
        }
    }
}

__global__ __launch_bounds__(256) void wkv_post_k(float* y, const float* __restrict__ prw, const float* __restrict__ mu, const float* __restrict__ bonus, const float* __restrict__ g,
                                                  const float* __restrict__ lnw, const float* __restrict__ lnb) {
    const int idx = blockIdx.x * 4 + (threadIdx.x >> 6), lane = threadIdx.x & 63;
    const int t = idx / NH, h = idx % NH, col = h * HD + lane;
    const float v = y[(size_t)t * DR + col];
    const float m = wave_sum(v) * (1.f / 64.f);
    const float d = v - m;
    const float var = wave_sum(d * d) * (1.f / 64.f);
    const float yn = d * rsqrtf(var + LN_X_EPS) * lnw[col] + lnb[col];
    const float vv = shiftmix(prw, mu, t, 1024 + col);
    y[(size_t)t * DR + col] = (yn + bonus[(size_t)t * NH + h] * vv) * g[(size_t)t * DR + col];
}

__global__ __launch_bounds__(256) void conv_k(const float* __restrict__ pcv, const float* __restrict__ cw, float* __restrict__ ob) {
    const size_t idx = (size_t)blockIdx.x * 256 + threadIdx.x;
    const int t = (int)(idx / 512), c = (int)(idx % 512), tl = t % SEQ;
    const float* p = pcv + (size_t)t * 1536;
    float u0 = p[512 + c] * p[1024 + c];
    float u1 = (tl >= 1) ? p[-1536 + 512 + c] * p[-1536 + 1024 + c] : 0.f;
    float u2 = (tl >= 2) ? p[-3072 + 512 + c] * p[-3072 + 1024 + c] : 0.f;
    ob[idx] = p[c] * (cw[c] * u2 + cw[512 + c] * u1 + cw[1024 + c] * u0);
}

__global__ __launch_bounds__(256) void xattn_k(const float* __restrict__ q, const float* __restrict__ kv, float* __restrict__ o) {
    __shared__ float sq[16][256];
    __shared__ float sp[16][257];
    const int tid = threadIdx.x, lane = tid & 63, wid = tid >> 6;
    const int tb = blockIdx.x, hh = blockIdx.y, b = (tb * 16) / SEQ;
    const int t0 = tb * 16;
    for (int i = tid; i < 16 * 256; i += 256) { const int r = i >> 8, d = i & 255; sq[r][d] = q[(size_t)(t0 + r) * DM + hh * XD + d]; }
    __syncthreads();
    {
        const int m = tid; const float* kr = kv + (size_t)(b * NMEM + m) * 2048 + hh * XD;
        float s[16];
#pragma unroll
        for (int r = 0; r < 16; ++r) s[r] = 0.f;
        for (int d = 0; d < 256; d += 4) {
            const float4 k4 = *(const float4*)(kr + d);
#pragma unroll
            for (int r = 0; r < 16; ++r) { const float4 q4 = *(const float4*)&sq[r][d]; s[r] += q4.x * k4.x + q4.y * k4.y + q4.z * k4.z + q4.w * k4.w; }
        }
#pragma unroll
        for (int r = 0; r < 16; ++r) sp[r][m] = s[r] * (1.f / 16.f);
    }
    __syncthreads();
    for (int r = wid * 4; r < wid * 4 + 4; ++r) {
        float v[4], mx = -1e30f;
#pragma unroll
        for (int j = 0; j < 4; ++j) { v[j] = sp[r][lane + 64 * j]; mx = fmaxf(mx, v[j]); }
#pragma unroll
        for (int oo = 1; oo < 64; oo <<= 1) mx = fmaxf(mx, __shfl_xor(mx, oo));
        float sm = 0.f;
#pragma unroll
        for (int j = 0; j < 4; ++j) { v[j] = __expf(v[j] - mx); sm += v[j]; }
        sm = wave_sum(sm); const float inv = 1.f / sm;
#pragma unroll
        for (int j = 0; j < 4; ++j) sp[r][lane + 64 * j] = v[j] * inv;
    }
    __syncthreads();
    {
        const int d = tid; const float* vb = kv + (size_t)(b * NMEM) * 2048 + 1024 + hh * XD + d;
        float acc[16];
#pragma unroll
        for (int r = 0; r < 16; ++r) acc[r] = 0.f;
        for (int m = 0; m < 256; ++m) {
            const float vv = vb[(size_t)m * 2048];
#pragma unroll
            for (int r = 0; r < 16; ++r) acc[r] = fmaf(sp[r][m], vv, acc[r]);
        }
#pragma unroll
        for (int r = 0; r < 16; ++r) o[(size_t)(t0 + r) * DM + hh * XD + d] = acc[r];
    }
}

extern "C" void kernel_launch(void* const* d_in, const int* in_sizes, int n_in, void* d_out, int out_size, void* d_ws, size_t ws_size, hipStream_t stream) {
    const float* x = (const float*)d_in[0];      const float* mem = (const float*)d_in[1];    const float* norm_mix = (const float*)d_in[2];
    const float* w_in = (const float*)d_in[3];   const float* b_gate = (const float*)d_in[4]; const float* mu = (const float*)d_in[5];
    const float* w0 = (const float*)d_in[6];     const float* wlw = (const float*)d_in[7];    const float* a0 = (const float*)d_in[8];
    const float* wla = (const float*)d_in[9];    const float* wlg = (const float*)d_in[10];   const float* k_k = (const float*)d_in[11];
    const float* k_a = (const float*)d_in[12];   const float* r_k = (const float*)d_in[13];   const float* lnw = (const float*)d_in[14];
    const float* lnb = (const float*)d_in[15];   const float* conv_w = (const float*)d_in[16];const float* wpa = (const float*)d_in[17];
    const float* wpb = (const float*)d_in[18];   const float* wout = (const float*)d_in[19];  const float* norm_x = (const float*)d_in[20];
    const float* norm_mem = (const float*)d_in[21]; const float* wq = (const float*)d_in[22]; const float* wkv = (const float*)d_in[23];
    const float* wxo = (const float*)d_in[24];   const float* norm_mlp = (const float*)d_in[25]; const float* wup = (const float*)d_in[26];
    const float* wdown = (const float*)d_in[27]; const float* norm_final = (const float*)d_in[28];
    float* out = (float*)d_out; char* ws = (char*)d_ws;
    constexpr size_t MiB = 1u << 20;
    if (n_in != 29 || ws_size < 256 * MiB) { fprintf(stderr, "kernel_launch: unexpected n_in %d / ws %zu\n", n_in, ws_size); return; }
    auto W = [&](size_t mib) { return (float*)(ws + mib * MiB); };
    float* H = out;
    float *PRW = W(0), *TWD = W(120), *AD = W(124), *SGD = W(128), *LWP = W(140), *APR = W(172), *G = W(204), *BON = W(236);
    hipLaunchKernelGGL(rmsnorm_k, dim3(T / 4), dim3(256), 0, stream, x, norm_mix, H, T);
    gemm<EPI_STORE>(stream, H, DM, w_in, DIN, PRW, RWC, T, RWC, DM);
    hipLaunchKernelGGL(lora_in_k, dim3((T * 288 + 255) / 256), dim3(256), 0, stream, PRW, mu, TWD, AD, SGD);
    gemm<EPI_STORE>(stream, TWD, 64, wlw, DR, LWP, DR, T, DR, 64);
    gemm<EPI_STORE>(stream, AD, 64, wla, DR, APR, DR, T, DR, 64);
    gemm<EPI_STORE>(stream, SGD, 160, wlg, DR, G, DR, T, DR, 160);
    hipLaunchKernelGGL(wkv_scan_k, dim3(NB * NH), dim3(256), 0, stream, PRW, mu, LWP, APR, w0, a0, k_k, k_a, r_k, BON);
    hipLaunchKernelGGL(wkv_post_k, dim3(T * NH / 4), dim3(256), 0, stream, LWP, PRW, mu, BON, G, lnw, lnb);
    float* OUT_A = LWP;
    float *PCV = W(0), *OUT_B = W(96);
    gemm<EPI_STORE>(stream, H, DM, w_in + RWC, DIN, PCV, 1536, T, 1536, DM);
    hipLaunchKernelGGL(conv_k, dim3(T * 512 / 256), dim3(256), 0, stream, PCV, conv_w, OUT_B);
    float *MERGED = W(172), *GB = W(0), *X1 = W(172);
    gemm<EPI_STORE>(stream, H, DM, w_in + 3360, DIN, MERGED, DM, T, DM, DM);
    gemm<EPI_SIGGATE>(stream, OUT_A, DR, wpa, DM, MERGED, DM, T, DM, DR, nullptr, 0, b_gate);
    gemm<EPI_STORE>(stream, H, DM, w_in + 4384, DIN, GB, DM, T, DM, DM);
    gemm<EPI_SIGGATE>(stream, OUT_B, DR, wpb, DM, GB, DM, T, DM, DR, MERGED, DM, b_gate + DM);
    gemm<EPI_RESID>(stream, GB, DM, wout, DM, X1, DM, T, DM, DM, x, DM);
    float *HQ = W(64), *Q = W(0), *MEMN = W(128), *KV = W(130), *O = W(64), *X2 = W(0);
    hipLaunchKernelGGL(rmsnorm_k, dim3(T / 4), dim3(256), 0, stream, X1, norm_x, HQ, T);
    gemm<EPI_STORE>(stream, HQ, DM, wq, DM, Q, DM, T, DM, DM);
    hipLaunchKernelGGL(rmsnorm_k, dim3(NB * NMEM / 4), dim3(256), 0, stream, mem, norm_mem, MEMN, NB * NMEM);
    gemm<EPI_STORE>(stream, MEMN, DM, wkv, 2048, KV, 2048, NB * NMEM, 2048, DM);
    hipLaunchKernelGGL(xattn_k, dim3(T / 16, XH), dim3(256), 0, stream, Q, KV, O);
    gemm<EPI_RESID>(stream, O, DM, wxo, DM, X2, DM, T, DM, DM, X1, DM);
    float *HM = W(64), *HID = W(128), *X3 = W(192);
    hipLaunchKernelGGL(rmsnorm_k, dim3(T / 4), dim3(256), 0, stream, X2, norm_mlp, HM, T);
    for (int c = 0; c < 4; ++c) {
        gemm<EPI_RELU2>(stream, HM, DM, wup + c * 1024, DFF, HID, DM, T, DM, DM);
        gemm<EPI_RESID>(stream, HID, DM, wdown + (size_t)c * 1024 * DM, DM, X3, DM, T, DM, DM, c == 0 ? X2 : X3, DM);
    }
    hipLaunchKernelGGL(rmsnorm_k, dim3(T / 4), dim3(256), 0, stream, X3, norm_final, out, T);
}
```

```cpp
#include <hip/hip_runtime.h>
#include <cstdio>
#include <cstdint>

__device__ __forceinline__ int lane_id_v() { int l; asm volatile("v_mbcnt_lo_u32_b32 %0, -1, 0\n\tv_mbcnt_hi_u32_b32 %0, -1, %0" : "=v"(l)); return l; }
namespace pg8 {
#define PG8_LAS __attribute__((address_space(3)))
typedef unsigned short bf16_t;
typedef short bf16x8 __attribute__((ext_vector_type(8)));
typedef float f32x4 __attribute__((ext_vector_type(4)));
typedef unsigned u32x4 __attribute__((ext_vector_type(4)));
constexpr int BM = 256, BK = 64, HALF = 128, HTB = HALF * BK * 2, STAGE_BYTES = 8 * HTB, NXCD = 8, WGM = 8;

__host__ __device__ __forceinline__ int lds_byte(int r, int c) { const int st = (r >> 4) * 2 + (c >> 5), rr = r & 15, cc = c & 31, ob = rr * 64 + cc * 2; return st * 1024 + (ob ^ (((ob >> 9) & 1) << 5)); }
__host__ __device__ __forceinline__ void stage_rc(int b, int& R, int& C) { const int st = b / 1024, sb = b % 1024, swz = sb ^ (((sb >> 9) & 1) << 5); R = (st >> 1) * 16 + swz / 64; C = (st & 1) * 32 + (swz % 64) / 2; }
__host__ __device__ __forceinline__ int perm32(int rho) { const int n = rho >> 4, i = rho & 15; return 8 * (i >> 2) + 4 * n + (i & 3); }

struct Unit { int pm, pn; size_t aoff, boff; };
struct Gemm { const bf16_t* A; const bf16_t* Bt; int lda, ldb, K; };

struct StaticOrder {
    int nM, nN, nwg, G, c, lda, ldb;
    __device__ void init(int M, int N, int G_, int c_, int lda_, int ldb_) { nM = M / BM; nN = N / BM; nwg = nM * nN; G = G_; c = c_; lda = lda_; ldb = ldb_; }
    __device__ bool next(int i, Unit& u) const {
        const long L = (long)i * G + c; if (L >= nwg) return false;
        int wgid = (int)L; { const int q = nwg / NXCD, r = nwg % NXCD, xcd = wgid % NXCD, off = wgid / NXCD; wgid = (xcd < r ? xcd * (q + 1) : r * (q + 1) + (xcd - r) * q) + off; }
        const int nig = WGM * nN, gid = wgid / nig, fm = gid * WGM, gsz = (nM - fm) < WGM ? (nM - fm) : WGM;
        u.pm = fm + ((wgid % nig) % gsz); u.pn = (wgid % nig) / gsz;
        u.aoff = (size_t)u.pm * BM * lda * 2; u.boff = (size_t)u.pn * BM * ldb * 2; return true;
    }
};
struct AttnOrder {
    int G, c; size_t bstride_b, bstride_h;
    __device__ bool next(int i, Unit& u) const {
        const int L = i * G + c; if (L >= 256) return false;
        u.pm = L >> 2; u.pn = L & 3;
        u.aoff = ((size_t)u.pm * BM * 1024 + u.pn * 256) * 2; u.boff = (size_t)(u.pm >> 5) * bstride_b + (size_t)u.pn * bstride_h; return true;
    }
};

__device__ __forceinline__ unsigned cvt_pk_bf16(float lo, float hi) { unsigned r; asm volatile("v_cvt_pk_bf16_f32 %0, %1, %2" : "=v"(r) : "v"(lo), "v"(hi)); return r; }

template <class Epi, class Sched>
__device__ __forceinline__ void gemm_phase(PG8_LAS unsigned char* lds, const int wid, const Gemm g, const Sched& S, const Epi& E) {
    const int lane = lane_id_v(), tid = wid * 64 + lane, wr = wid >> 2, wc = wid & 3, fr = lane & 15, fq = lane >> 4;
    const int K = g.K, nt = K / BK;
    unsigned voffA[2], voffB[2];
#pragma unroll
    for (int i = 0; i < 2; ++i) { int R, C; stage_rc(tid * 16 + i * 8192, R, C); const int Rb = (R & ~31) + perm32(R & 31);
        voffA[i] = (unsigned)(R * g.lda + C) * 2u; voffB[i] = (unsigned)(Rb * g.ldb + C) * 2u; }
    const size_t kstep = (size_t)(BK * 2);
    const size_t hA = (size_t)HALF * g.lda * 2, hB = (size_t)HALF * g.ldb * 2;
    const unsigned ldsw = (unsigned)wid * 1024u;
    const int aoff = lds_byte(wr * 64 + fr, fq * 8), boff = lds_byte(wc * 32 + fr, fq * 8);
#define PG8_SA(b, h) (((b) * 2 + (h)) * HTB)
#define PG8_SB(b, h) ((4 + (b) * 2 + (h)) * HTB)
#define PG8_STAGE(bufoff, gbase, voff) do { _Pragma("unroll") for (int _i = 0; _i < 2; ++_i) \
        __builtin_amdgcn_global_load_lds((const unsigned*)((const char*)(gbase) + (voff)[_i]), (PG8_LAS unsigned*)(lds + (bufoff) + ldsw + _i * 8192), 16, 0, 0); } while (0)
#define PG8_LDA(dst, b, h) do { _Pragma("unroll") for (int m = 0; m < 4; ++m) _Pragma("unroll") for (int k = 0; k < 2; ++k) dst[m][k] = *(const PG8_LAS bf16x8*)(lds + PG8_SA(b, h) + aoff + m * 2048 + k * 1024); } while (0)
#define PG8_LDB(dst, b, h) do { _Pragma("unroll") for (int n = 0; n < 2; ++n) _Pragma("unroll") for (int k = 0; k < 2; ++k) dst[n][k] = *(const PG8_LAS bf16x8*)(lds + PG8_SB(b, h) + boff + n * 2048 + k * 1024); } while (0)
#define PG8_MMA(ai, bj, At, Bt) do { __builtin_amdgcn_s_setprio(1); _Pragma("unroll") for (int m = 0; m < 4; ++m) _Pragma("unroll") for (int n = 0; n < 2; ++n) _Pragma("unroll") for (int k = 0; k < 2; ++k) \
        acc[ai][bj][m][n] = __builtin_amdgcn_mfma_f32_16x16x32_bf16(Bt[n][k], At[m][k], acc[ai][bj][m][n], 0, 0, 0); __builtin_amdgcn_s_setprio(0); } while (0)
#define PG8_WAIT_V(n) asm volatile("s_waitcnt vmcnt(" #n ")" ::: "memory")
#define PG8_WAIT_L(n) asm volatile("s_waitcnt lgkmcnt(" #n ")" ::: "memory")
#define PG8_BAR __builtin_amdgcn_s_barrier()
#define PG8_SCHED __builtin_amdgcn_sched_barrier(0)
    Unit cur, nxt; int ui = 0;
    if (!S.next(0, cur)) return;
    f32x4 acc[2][2][4][2];
#pragma unroll
    for (int a = 0; a < 2; ++a)
#pragma unroll
        for (int b = 0; b < 2; ++b)
#pragma unroll
            for (int m = 0; m < 4; ++m)
#pragma unroll
                for (int n = 0; n < 2; ++n) acc[a][b][m][n] = (f32x4){0.f, 0.f, 0.f, 0.f};
    bf16x8 At[4][2], B0[2][2], B1[2][2];
    const char* cA = (const char*)g.A + cur.aoff; const char* cB = (const char*)g.Bt + cur.boff;
    PG8_STAGE(PG8_SB(0, 0), cB, voffB); PG8_STAGE(PG8_SB(0, 1), cB + hB, voffB); PG8_STAGE(PG8_SA(0, 0), cA, voffA); PG8_STAGE(PG8_SA(0, 1), cA + hA, voffA);
    if (wr == 1) PG8_BAR;
    PG8_WAIT_V(2); PG8_BAR;
    PG8_STAGE(PG8_SB(1, 0), cB + kstep, voffB); PG8_STAGE(PG8_SA(1, 0), cA + kstep, voffA); PG8_STAGE(PG8_SB(1, 1), cB + hB + kstep, voffB);
    PG8_WAIT_V(6); PG8_BAR;
    for (;;) {
        const bool has_next = S.next(ui + 1, nxt);
        const char* nA = has_next ? (const char*)g.A + nxt.aoff : cA; const char* nB = has_next ? (const char*)g.Bt + nxt.boff : cB;
        for (int t = 0; t < nt; t += 2) {
            const bool last = (t == nt - 2);
            const char* a1 = cA + (size_t)(t + 1) * kstep;
            const char* a2 = last ? nA : cA + (size_t)(t + 2) * kstep; const char* b2 = last ? nB : cB + (size_t)(t + 2) * kstep;
            const char* a3 = a2 + kstep; const char* b3 = b2 + kstep;
            PG8_LDB(B0, 0, 0); PG8_LDB(B1, 0, 1); PG8_SCHED; PG8_LDA(At, 0, 0); PG8_STAGE(PG8_SA(1, 1), a1 + hA, voffA);
            PG8_WAIT_V(8); PG8_WAIT_L(0); PG8_BAR; PG8_MMA(0, 0, At, B0); PG8_MMA(0, 1, At, B1); PG8_BAR; PG8_SCHED;
            PG8_LDA(At, 0, 1); PG8_STAGE(PG8_SB(0, 0), b2, voffB); PG8_STAGE(PG8_SB(0, 1), b2 + hB, voffB); PG8_STAGE(PG8_SA(0, 0), a2, voffA);
            PG8_WAIT_V(8); PG8_WAIT_L(0); PG8_BAR; PG8_MMA(1, 0, At, B0); PG8_MMA(1, 1, At, B1); PG8_BAR; PG8_SCHED;
            PG8_LDB(B0, 1, 0); PG8_LDB(B1, 1, 1); PG8_SCHED; PG8_LDA(At, 1, 0); PG8_STAGE(PG8_SA(0, 1), a2 + hA, voffA);
            PG8_WAIT_V(8); PG8_WAIT_L(0); PG8_BAR; PG8_MMA(0, 0, At, B0); PG8_MMA(0, 1, At, B1); PG8_BAR; PG8_SCHED;
            PG8_LDA(At, 1, 1); PG8_STAGE(PG8_SB(1, 0), b3, voffB); PG8_STAGE(PG8_SB(1, 1), b3 + hB, voffB); PG8_STAGE(PG8_SA(1, 0), a3, voffA);
            PG8_WAIT_V(8); PG8_WAIT_L(0); PG8_BAR; PG8_MMA(1, 0, At, B0); PG8_MMA(1, 1, At, B1); PG8_BAR; PG8_SCHED;
        }
        if constexpr (!Epi::AFTER_DRAIN) { if (wr == 0) PG8_BAR; const int l2 = lane_id_v(), fr2 = l2 & 15, fq2 = l2 >> 4;
            E(acc, cur, wr, wc, fr2, fq2); }
        if (!has_next) break;
#pragma unroll
        for (int a = 0; a < 2; ++a)
#pragma unroll
            for (int b = 0; b < 2; ++b)
#pragma unroll
                for (int m = 0; m < 4; ++m)
#pragma unroll
                    for (int n = 0; n < 2; ++n) acc[a][b][m][n] = (f32x4){0.f, 0.f, 0.f, 0.f};
        cur = nxt; cA = nA; cB = nB; ++ui;
        if constexpr (!Epi::AFTER_DRAIN) { if (wr == 1) PG8_BAR; }
    }
    PG8_WAIT_V(0);
    if constexpr (Epi::AFTER_DRAIN) { if (wr == 0) PG8_BAR; }
    PG8_BAR;
    if constexpr (Epi::AFTER_DRAIN) { const int l2 = lane_id_v(), fr2 = l2 & 15, fq2 = l2 >> 4; E.fused(acc, cur, wr, wc, fr2, fq2, lds, wid, l2); }
#undef PG8_SA
#undef PG8_SB
#undef PG8_STAGE
#undef PG8_LDA
#undef PG8_LDB
#undef PG8_MMA
#undef PG8_WAIT_V
#undef PG8_WAIT_L
#undef PG8_BAR
#undef PG8_SCHED
}
}

constexpr int NB = 2, SEQ = 8192, DM = 1024, T = NB * SEQ;
constexpr int DR = 512, NH = 8, HD = 64, RWC = 1824, DIN = 5408, DINP = 5632;
constexpr int NMEM = 256, XH = 4, XD = 256, DFF = 4096, LORA_K = 384, LORA_N = 1536;
constexpr float RMS_EPS = 1e-6f, LN_X_EPS = 64e-5f;
constexpr int NWAVES = 8;

constexpr size_t MiB = 1u << 20;
constexpr size_t WS_CTL = 0, CTL_ZERO_BYTES = 1 * MiB;
constexpr size_t WS_WIN = 2 * MiB;
constexpr size_t WS_WPA = 13 * MiB, WS_WPB = 14 * MiB, WS_WOUT = 15 * MiB, WS_WQ = 17 * MiB, WS_WKV = 19 * MiB, WS_WXO = 23 * MiB;
constexpr size_t WS_WUP = 25 * MiB, WS_WDN = 33 * MiB, WS_LORA = 41 * MiB;
constexpr size_t WS_MEMB = 43 * MiB;
constexpr size_t WS_KMAT = 44 * MiB;
constexpr size_t WS_VT = 45 * MiB;
constexpr size_t WS_XB = 48 * MiB;
constexpr size_t WS_AP = WS_XB, WS_OUTA = WS_XB, WS_OUTB = WS_XB + 16 * MiB;
constexpr size_t WS_PRKV = 80 * MiB;
constexpr size_t WS_PCV = 128 * MiB;
constexpr size_t WS_LW = WS_PCV, WS_ALR = WS_PCV + 32 * MiB;
constexpr size_t WS_PG = 176 * MiB;
constexpr size_t WS_PLI = 240 * MiB;
constexpr size_t WS_MA = 80 * MiB;
constexpr size_t WS_MERGED = 144 * MiB;
constexpr size_t WS_XB1 = 48 * MiB;
constexpr size_t WS_Q = 80 * MiB;
constexpr size_t WS_P = 112 * MiB;
constexpr size_t WS_O = 144 * MiB;
constexpr size_t WS_XB2 = 48 * MiB;
constexpr size_t WS_HID = 80 * MiB;
constexpr size_t WS_END = 256 * MiB;
constexpr int CW_BAR = 4096;
constexpr size_t CTL_RSTDX = 64 * 1024, CTL_RSTDM = 128 * 1024, CTL_SSQ1 = 192 * 1024, CTL_SSQ2 = 256 * 1024;

constexpr int RING_BYTES = 131072, LDSCTL_OFF = RING_BYTES, MISC_OFF = LDSCTL_OFF + 320, LDS_BYTES = 147456;

#define GAS __attribute__((address_space(1)))
#define LAS __attribute__((address_space(3)))
typedef unsigned short bf16;
typedef unsigned v4u __attribute__((ext_vector_type(4)));
typedef float f32x4 __attribute__((ext_vector_type(4)));
typedef GAS unsigned gu32;
#define RLX_AGENT __ATOMIC_RELAXED, __HIP_MEMORY_SCOPE_AGENT
#define LDS_WAIT() asm volatile("s_waitcnt lgkmcnt(0)" ::: "memory")
__device__ __forceinline__ unsigned f2bf(float f) { unsigned u = __builtin_bit_cast(unsigned, f); return (u + 0x7fffu + ((u >> 16) & 1u)) >> 16; }
__device__ __forceinline__ unsigned pk2(float lo, float hi) { return f2bf(lo) | (f2bf(hi) << 16); }
__device__ __forceinline__ float bf2f(unsigned short h) { return __builtin_bit_cast(float, (unsigned)h << 16); }
__device__ __forceinline__ float bflo(unsigned w) { return __builtin_bit_cast(float, w << 16); }
__device__ __forceinline__ float bfhi(unsigned w) { return __builtin_bit_cast(float, w & 0xffff0000u); }
__device__ __forceinline__ float sigmoidf_(float x) { return 1.f / (1.f + __expf(-x)); }
__device__ __forceinline__ float wave_sum(float v) {
#pragma unroll
    for (int o = 1; o < 64; o <<= 1) v += __shfl_xor(v, o);
    return v;
}

#define XB_TMO      128
#define XB_XCNT(j)  (256  + 64 * (j))
#define XB_XSUB(j)  (1280 + 64 * (j))
#define XB_XGEN(j)  (2304 + 64 * (j))
#define XB_TOP      3328
#define XB_TOPGEN   3392
#define XCD_BAR_WORDS 3456
#define XB_SPIN_CAP (1u << 20)
__device__ __forceinline__ unsigned xb_ld(unsigned* p)              { return __hip_atomic_load(p, __ATOMIC_RELAXED, __HIP_MEMORY_SCOPE_AGENT); }
__device__ __forceinline__ unsigned xb_add(unsigned* p, unsigned v) { return __hip_atomic_fetch_add(p, v, __ATOMIC_RELAXED, __HIP_MEMORY_SCOPE_AGENT); }
__device__ __forceinline__ unsigned xb_xcc_id() { return (unsigned)__builtin_amdgcn_s_getreg((3 << 11) | 20) & 0xFu; }
#define XB_SPIN(cond, bar) do { unsigned _sp = 0; while (cond) { __builtin_amdgcn_s_sleep(1); \
    if ((++_sp & 255u) == 0u) { if (xb_ld(&(bar)[XB_TMO])) break; if (_sp > XB_SPIN_CAP) { atomicAdd(&(bar)[XB_TMO], 1u); break; } } } } while (0)
struct XcdBarrier { unsigned* bar; unsigned x; volatile LAS unsigned* st; };
__device__ __forceinline__ XcdBarrier xcd_barrier_post(unsigned* bar, volatile LAS unsigned* st) {
    XcdBarrier b; b.bar = bar; b.x = xb_xcc_id(); b.st = st;
    if (threadIdx.x == 0) (void)xb_add(&bar[XB_XCNT(b.x)], 1u);
    return b;
}
__device__ __forceinline__ void xcd_barrier_complete(unsigned* bar, unsigned x, unsigned& nloc, unsigned& nx) {
    const unsigned G = gridDim.x * gridDim.y * gridDim.z;
    unsigned sum, cnt, mine, sp = 0u;
    for (;;) {
        sum = 0u; cnt = 0u; mine = 0u;
#pragma unroll
        for (unsigned j = 0; j < 16; ++j) { const unsigned c = xb_ld(&bar[XB_XCNT(j)]); sum += c; cnt += (c > 0u) ? 1u : 0u; mine = (j == x) ? c : mine; }
        if (sum == G) break;
        __builtin_amdgcn_s_sleep(1);
        if ((++sp & 255u) == 0u) { if (xb_ld(&bar[XB_TMO])) break; if (sp > XB_SPIN_CAP) { atomicAdd(&bar[XB_TMO], 1u); break; } }
    }
    nloc = mine > 0u ? mine : 1u; nx = cnt > 0u ? cnt : 1u;
}
__device__ __forceinline__ void xcd_barrier(const XcdBarrier& b, const int wave) {
    asm volatile("s_waitcnt vmcnt(0)" ::: "memory");
    __syncthreads();
    if (wave == 0 && lane_id_v() == 0) {
        unsigned* bar = b.bar;
        __builtin_amdgcn_s_waitcnt(0);
        unsigned nloc = b.st[0], nx = b.st[1];
        if (nloc == 0u) { xcd_barrier_complete(bar, b.x, nloc, nx); b.st[0] = nloc; b.st[1] = nx; }
        const unsigned old = xb_add(&bar[XB_XSUB(b.x)], 1u);
        const unsigned gen = old / nloc;
        if (old + 1u == (gen + 1u) * nloc) {
            __builtin_amdgcn_fence(__ATOMIC_RELEASE, "agent");
            asm volatile("s_waitcnt vmcnt(0)" ::: "memory");
            const unsigned og = xb_add(&bar[XB_TOP], 1u);
            const unsigned tg = og / nx;
            if (og + 1u == (tg + 1u) * nx) xb_add(&bar[XB_TOPGEN], 1u);
            else XB_SPIN(xb_ld(&bar[XB_TOPGEN]) == tg, bar);
            __builtin_amdgcn_fence(__ATOMIC_ACQUIRE, "agent");
            xb_add(&bar[XB_XGEN(b.x)], 1u);
            asm volatile("s_waitcnt vmcnt(0)" ::: "memory");
        } else {
            XB_SPIN(xb_ld(&bar[XB_XGEN(b.x)]) == gen, bar);
            __builtin_amdgcn_fence(__ATOMIC_ACQUIRE, "agent");
            asm volatile("s_waitcnt vmcnt(0)" ::: "memory");
        }
    }
    __syncthreads();
}

using pg8::f32x4; using pg8::u32x4; using pg8::Unit; using pg8::cvt_pk_bf16;
#define EPI_ROWS(ai, m) (u.pm * 256 + (ai) * 128 + wr * 64 + (m) * 16 + fr)
#define EPI_CL(bj) ((bj) * 128 + wc * 32 + 8 * fq)
__device__ __forceinline__ u32x4 pack8(f32x4 v0, f32x4 v1) { u32x4 w; w.x = cvt_pk_bf16(v0[0], v0[1]); w.y = cvt_pk_bf16(v0[2], v0[3]); w.z = cvt_pk_bf16(v1[0], v1[1]); w.w = cvt_pk_bf16(v1[2], v1[3]); return w; }
__device__ __forceinline__ void unpack8(u32x4 w, f32x4& v0, f32x4& v1) { v0 = (f32x4){bflo(w.x), bfhi(w.x), bflo(w.y), bfhi(w.y)}; v1 = (f32x4){bflo(w.z), bfhi(w.z), bflo(w.w), bfhi(w.w)}; }

struct EpiRoute {
    static constexpr bool AFTER_DRAIN = false;
    bf16 *prkv, *pcv, *pg, *pli; const float* rstd;
    __device__ __forceinline__ void operator()(const f32x4 (&acc)[2][2][4][2], const Unit& u, int wr, int wc, int fr, int fq) const {
        bf16* base; int ld, c0, lim;
        if (u.pn < 6) { base = prkv; ld = 1536; c0 = u.pn * 256; lim = 1536; }
        else if (u.pn < 12) { base = pcv; ld = 1536; c0 = (u.pn - 6) * 256; lim = 1536; }
        else if (u.pn < 20) { base = pg; ld = 2048; c0 = (u.pn - 12) * 256; lim = 2048; }
        else { base = pli; ld = 288; c0 = (u.pn - 20) * 256; lim = 288; }
#pragma unroll
        for (int ai = 0; ai < 2; ++ai)
#pragma unroll
            for (int m = 0; m < 4; ++m) { const int row = EPI_ROWS(ai, m); const float s = rstd[row];
#pragma unroll
                for (int bj = 0; bj < 2; ++bj) { const int c = c0 + EPI_CL(bj);
                    if (c < lim) *(u32x4*)(base + (size_t)row * ld + c) = pack8(acc[ai][bj][m][0] * s, acc[ai][bj][m][1] * s); } }
    }
};
struct EpiLora {
    static constexpr bool AFTER_DRAIN = false;
    float* lw; bf16* alr; bf16* g; const float* w0; const float* a0;
    __device__ __forceinline__ void operator()(const f32x4 (&acc)[2][2][4][2], const Unit& u, int wr, int wc, int fr, int fq) const {
        const int kind = u.pn >> 1, cb = (u.pn & 1) * 256;
#pragma unroll
        for (int bj = 0; bj < 2; ++bj) { const int c = cb + EPI_CL(bj);
            f32x4 b0 = (f32x4){0.f, 0.f, 0.f, 0.f}, b1 = b0;
            if (kind == 0) { b0 = *(const f32x4*)(w0 + c); b1 = *(const f32x4*)(w0 + c + 4); }
            if (kind == 1) { b0 = *(const f32x4*)(a0 + c); b1 = *(const f32x4*)(a0 + c + 4); }
#pragma unroll
            for (int ai = 0; ai < 2; ++ai)
#pragma unroll
                for (int m = 0; m < 4; ++m) { const int row = EPI_ROWS(ai, m);
                    f32x4 v0 = acc[ai][bj][m][0] + b0, v1 = acc[ai][bj][m][1] + b1;
                    if (kind == 0) { float* p = lw + (size_t)row * DR + c; *(f32x4*)p = v0; *(f32x4*)(p + 4) = v1; }
                    else if (kind == 1) *(u32x4*)(alr + (size_t)row * DR + c) = pack8(v0, v1);
                    else *(u32x4*)(g + (size_t)row * DR + c) = pack8(v0, v1);
                } }
    }
};
template <int SECOND> struct EpiGate {
    static constexpr bool AFTER_DRAIN = false;
    const bf16* pg; int goff; const float* bias; float* ma; bf16* merged;
    __device__ __forceinline__ void operator()(const f32x4 (&acc)[2][2][4][2], const Unit& u, int wr, int wc, int fr, int fq) const {
#pragma unroll
        for (int bj = 0; bj < 2; ++bj) { const int c = u.pn * 256 + EPI_CL(bj);
            const f32x4 b0 = *(const f32x4*)(bias + c), b1 = *(const f32x4*)(bias + c + 4);
#pragma unroll
            for (int ai = 0; ai < 2; ++ai)
#pragma unroll
                for (int m = 0; m < 4; ++m) { const int row = EPI_ROWS(ai, m);
                    f32x4 g0, g1; unpack8(*(const u32x4*)(pg + (size_t)row * 2048 + goff + c), g0, g1);
                    f32x4 v0 = acc[ai][bj][m][0], v1 = acc[ai][bj][m][1];
#pragma unroll
                    for (int e = 0; e < 4; ++e) { v0[e] *= sigmoidf_(g0[e] + b0[e]); v1[e] *= sigmoidf_(g1[e] + b1[e]); }
                    float* p = ma + (size_t)row * DM + c;
                    if (SECOND) { v0 += *(const f32x4*)p; v1 += *(const f32x4*)(p + 4); *(u32x4*)(merged + (size_t)row * DM + c) = pack8(v0, v1); }
                    else { *(f32x4*)p = v0; *(f32x4*)(p + 4) = v1; }
                } }
    }
};
template <int WITH_XB> struct EpiResid {
    static constexpr bool AFTER_DRAIN = false;
    const float* R; float* out; bf16* xb; float* ssq;
    __device__ __forceinline__ void operator()(const f32x4 (&acc)[2][2][4][2], const Unit& u, int wr, int wc, int fr, int fq) const {
#pragma unroll
        for (int ai = 0; ai < 2; ++ai)
#pragma unroll
            for (int m = 0; m < 4; ++m) { const int row = EPI_ROWS(ai, m); float s = 0.f;
#pragma unroll
                for (int bj = 0; bj < 2; ++bj) { const size_t off = (size_t)row * DM + u.pn * 256 + EPI_CL(bj);
                    const f32x4 v0 = acc[ai][bj][m][0] + *(const f32x4*)(R + off), v1 = acc[ai][bj][m][1] + *(const f32x4*)(R + off + 4);
                    *(f32x4*)(out + off) = v0; *(f32x4*)(out + off + 4) = v1;
                    if (WITH_XB) { *(u32x4*)(xb + off) = pack8(v0, v1);
                        s += (v0[0] * v0[0] + v0[1] * v0[1]) + (v0[2] * v0[2] + v0[3] * v0[3]) + (v1[0] * v1[0] + v1[1] * v1[1]) + (v1[2] * v1[2] + v1[3] * v1[3]); } }
                if (WITH_XB) { s += __shfl_xor(s, 16); s += __shfl_xor(s, 32); if (fq == 0) atomicAdd(ssq + row, s); } }
    }
};
template <int MODE> struct EpiRowBf16 {
    static constexpr bool AFTER_DRAIN = false;
    bf16* out; int ldc; int coloff_mul; const float* rs; float scale;
    __device__ __forceinline__ void operator()(const f32x4 (&acc)[2][2][4][2], const Unit& u, int wr, int wc, int fr, int fq) const {
#pragma unroll
        for (int ai = 0; ai < 2; ++ai)
#pragma unroll
            for (int m = 0; m < 4; ++m) { const int row = EPI_ROWS(ai, m);
                float s = 1.f;
                if (MODE == 0) s = rs[row];
                if (MODE == 1 || MODE == 2) s = rsqrtf(rs[row] * (1.f / DM) + RMS_EPS) * scale;
#pragma unroll
                for (int bj = 0; bj < 2; ++bj) { const int c = u.pn * coloff_mul + EPI_CL(bj);
                    f32x4 v0 = acc[ai][bj][m][0] * s, v1 = acc[ai][bj][m][1] * s;
                    if (MODE == 2) {
#pragma unroll
                        for (int e = 0; e < 4; ++e) { v0[e] = fmaxf(v0[e], 0.f); v0[e] *= v0[e]; v1[e] = fmaxf(v1[e], 0.f); v1[e] *= v1[e]; } }
                    if (MODE == 3) { v0 *= *(const f32x4*)(rs + c); v1 *= *(const f32x4*)(rs + c + 4); }
                    *(u32x4*)(out + (size_t)row * ldc + c) = pack8(v0, v1); } }
    }
};
struct EpiSoftmax {
    static constexpr bool AFTER_DRAIN = true;
    bf16* P;
    __device__ __forceinline__ void fused(f32x4 (&acc)[2][2][4][2], const Unit& u, int wr, int wc, int fr, int fq, LAS unsigned char* lds, int wid, int lane) const {
        LAS float* X = (LAS float*)lds;
        LAS float* Y = (LAS float*)(lds + 4096);
#pragma unroll
        for (int ai = 0; ai < 2; ++ai)
#pragma unroll
            for (int m = 0; m < 4; ++m) { float mx = -3.0e38f;
#pragma unroll
                for (int bj = 0; bj < 2; ++bj)
#pragma unroll
                    for (int n = 0; n < 2; ++n) { const f32x4 v = acc[ai][bj][m][n]; mx = fmaxf(fmaxf(mx, fmaxf(v[0], v[1])), fmaxf(v[2], v[3])); }
                mx = fmaxf(mx, __shfl_xor(mx, 16)); mx = fmaxf(mx, __shfl_xor(mx, 32));
                if (fq == 0) X[(ai * 128 + wr * 64 + m * 16 + fr) * 4 + wc] = mx; }
        LDS_WAIT(); __builtin_amdgcn_s_barrier(); asm volatile("" ::: "memory");
#pragma unroll
        for (int ai = 0; ai < 2; ++ai)
#pragma unroll
            for (int m = 0; m < 4; ++m) { const int r = ai * 128 + wr * 64 + m * 16 + fr;
                const f32x4 q = *(const LAS f32x4*)(X + r * 4); const float mx = fmaxf(fmaxf(q[0], q[1]), fmaxf(q[2], q[3])); float s = 0.f;
#pragma unroll
                for (int bj = 0; bj < 2; ++bj)
#pragma unroll
                    for (int n = 0; n < 2; ++n) {
#pragma unroll
                        for (int e = 0; e < 4; ++e) { const float p = __builtin_amdgcn_exp2f(acc[ai][bj][m][n][e] - mx); acc[ai][bj][m][n][e] = p; s += p; } }
                s += __shfl_xor(s, 16); s += __shfl_xor(s, 32);
                if (fq == 0) Y[r * 4 + wc] = s; }
        LDS_WAIT(); __builtin_amdgcn_s_barrier(); asm volatile("" ::: "memory");
#pragma unroll
        for (int ai = 0; ai < 2; ++ai)
#pragma unroll
            for (int m = 0; m < 4; ++m) { const int r = ai * 128 + wr * 64 + m * 16 + fr;
                const f32x4 q = *(const LAS f32x4*)(Y + r * 4); const float inv = 1.f / ((q[0] + q[1]) + (q[2] + q[3]));
#pragma unroll
                for (int bj = 0; bj < 2; ++bj)
                    *(u32x4*)(P + (size_t)(u.pm * 256 + r) * DM + u.pn * 256 + EPI_CL(bj)) = pack8(acc[ai][bj][m][0] * inv, acc[ai][bj][m][1] * inv); }
        LDS_WAIT(); __builtin_amdgcn_s_barrier(); asm volatile("" ::: "memory");
    }
};

struct Frame {
    LAS unsigned char* lds; volatile LAS unsigned* MISC;
    int wave, vcu, G;
};

__device__ __forceinline__ void p0_transpose_item(const float* W, int ldn, int ncols, int K, const float* kscale, bf16* WT, int row_off, LAS float* scr, int item, int lane) {
    const int nblk = ncols / 32, kb = item / nblk, nb = item % nblk, k0 = 64 * kb, n0 = 32 * nb;
#pragma unroll 8
    for (int i = 0; i < 32; ++i) { const int kk = 2 * i + (lane >> 5); float w = W[(size_t)(k0 + kk) * ldn + n0 + (lane & 31)]; if (kscale) w *= kscale[k0 + kk]; scr[kk * 33 + (lane & 31)] = w; }
    LDS_WAIT(); asm volatile("" ::: "memory");
    const int c = lane & 7;
#pragma unroll
    for (int j = 0; j < 4; ++j) { const int n = (lane >> 3) + 8 * j; const LAS float* s = scr + (8 * c) * 33 + n;
        v4u o; o.x = pk2(s[0 * 33], s[1 * 33]); o.y = pk2(s[2 * 33], s[3 * 33]); o.z = pk2(s[4 * 33], s[5 * 33]); o.w = pk2(s[6 * 33], s[7 * 33]);
        *(GAS v4u*)(WT + (size_t)(row_off + n0 + n) * K + k0 + 8 * c) = o; }
    LDS_WAIT(); asm volatile("" ::: "memory");
}
__device__ __forceinline__ void row_to_bf16_rstd(int lane, const float* xrow, bf16* orow, float* rstd_out) {
    const GAS f32x4* xr = (const GAS f32x4*)xrow + lane;
    f32x4 v[4]; float s = 0.f;
#pragma unroll
    for (int j = 0; j < 4; ++j) { v[j] = xr[64 * j]; s += (v[j].x * v[j].x + v[j].y * v[j].y) + (v[j].z * v[j].z + v[j].w * v[j].w); }
    const float r = rsqrtf(wave_sum(s) * (1.f / DM) + RMS_EPS);
    GAS unsigned long long* o8 = (GAS unsigned long long*)orow + lane;
#pragma unroll
    for (int j = 0; j < 4; ++j) o8[64 * j] = (unsigned long long)pk2(v[j].x, v[j].y) | ((unsigned long long)pk2(v[j].z, v[j].w) << 32);
    if (lane == 0) *rstd_out = r;
}

struct Args { const float* in[29]; float* out; unsigned char* ws; int ph_lo, ph_hi; };
constexpr int N_PHASES = 14;
typedef const Args __attribute__((address_space(4)))* KArgsP;
__device__ __forceinline__ KArgsP kargs() { KArgsP p = (KArgsP)__builtin_amdgcn_kernarg_segment_ptr(); asm volatile("" : "+s"(p)); return p; }
#define IN_(i) ((const float*)ka->in[i])
#define WSP(T_, off) ((T_*)(ws + (off)))

__global__ void __launch_bounds__(NWAVES * 64, 2) mk_fwd(Args args_unused) {
    extern __shared__ __attribute__((aligned(16))) unsigned char lds[];
    Frame F;
    F.lds = (LAS unsigned char*)lds;
    F.MISC = (volatile LAS unsigned*)(F.lds + MISC_OFF);
    F.wave = __builtin_amdgcn_readfirstlane((int)threadIdx.x >> 6);
    F.G = gridDim.x; { const int bx = blockIdx.x; F.vcu = (F.G % 8 == 0) ? (bx % 8) * (F.G / 8) + bx / 8 : bx; }
    for (int u = threadIdx.x; u < (LDS_BYTES - LDSCTL_OFF) / 4; u += NWAVES * 64) ((LAS unsigned*)(F.lds + LDSCTL_OFF))[u] = 0u;
    __syncthreads();
    int lo, hi; { KArgsP ka = kargs(); lo = ka->ph_lo; hi = ka->ph_hi; }
    const bool use_bar = (hi - lo) > 1;
    if (use_bar) { KArgsP ka = kargs(); (void)xcd_barrier_post((unsigned*)(ka->ws + WS_CTL) + CW_BAR, F.MISC + 8); }
#define IN(k) (lo <= (k) && (k) < hi)
#define SEAM(k) do { if (IN(k) && IN((k) + 1)) { KArgsP ka_ = kargs(); XcdBarrier b_; b_.bar = (unsigned*)(ka_->ws + WS_CTL) + CW_BAR; b_.x = xb_xcc_id(); b_.st = F.MISC + 8; xcd_barrier(b_, F.wave); } } while (0)
    const int gw = F.vcu * NWAVES + F.wave, NGW = F.G * NWAVES;
    const int NGT = F.G * NWAVES * 64;
#define PHASE_IDS const int LANE = lane_id_v(), TID = F.wave * 64 + LANE, gt = blockIdx.x * (NWAVES * 64) + TID; (void)gt; (void)TID
#define PHASE_KA KArgsP ka = kargs(); unsigned char* ws = ka->ws; (void)ws

    if (IN(0)) {
        PHASE_IDS; PHASE_KA;
        LAS float* scr = (LAS float*)(F.lds + F.wave * 16384);
        constexpr int I0 = 16 * 48, I1 = 16 * 112, I2 = 16 * 9, IPA = 8 * 32, IOUT = 16 * 32, IKV = 16 * 64, IUP = 16 * 128, IDN = 64 * 32;
        constexpr int NITEMS = I0 + I1 + I2 + 2 * IPA + 3 * IOUT + IKV + IUP + IDN;
        bf16* WinT = WSP(bf16, WS_WIN);
        for (int it = gw; it < NITEMS; it += NGW) {
            int r = it;
            if (r < I0) { p0_transpose_item(IN_(3), DIN, 1536, DM, IN_(2), WinT, 0, scr, r, LANE); continue; } r -= I0;
            if (r < I1) { p0_transpose_item(IN_(3) + 1824, DIN, 3584, DM, IN_(2), WinT, 1536, scr, r, LANE); continue; } r -= I1;
            if (r < I2) { p0_transpose_item(IN_(3) + 1536, DIN, 288, DM, IN_(2), WinT, 5120, scr, r, LANE); continue; } r -= I2;
            if (r < IPA) { p0_transpose_item(IN_(17), DM, DM, DR, nullptr, WSP(bf16, WS_WPA), 0, scr, r, LANE); continue; } r -= IPA;
            if (r < IPA) { p0_transpose_item(IN_(18), DM, DM, DR, nullptr, WSP(bf16, WS_WPB), 0, scr, r, LANE); continue; } r -= IPA;
            if (r < IOUT) { p0_transpose_item(IN_(19), DM, DM, DM, nullptr, WSP(bf16, WS_WOUT), 0, scr, r, LANE); continue; } r -= IOUT;
            if (r < IOUT) { p0_transpose_item(IN_(22), DM, DM, DM, IN_(20), WSP(bf16, WS_WQ), 0, scr, r, LANE); continue; } r -= IOUT;
            if (r < IOUT) { p0_transpose_item(IN_(24), DM, DM, DM, nullptr, WSP(bf16, WS_WXO), 0, scr, r, LANE); continue; } r -= IOUT;
            if (r < IKV) { p0_transpose_item(IN_(23), 2048, 2048, DM, IN_(21), WSP(bf16, WS_WKV), 0, scr, r, LANE); continue; } r -= IKV;
            if (r < IUP) { p0_transpose_item(IN_(26), DFF, DFF, DM, IN_(25), WSP(bf16, WS_WUP), 0, scr, r, LANE); continue; } r -= IUP;
            p0_transpose_item(IN_(27), DM, DM, DFF, nullptr, WSP(bf16, WS_WDN), 0, scr, r, LANE);
        }
        for (int i = gt; i < 224 * 1024 / 8; i += NGT) ((v4u*)(WinT + (size_t)DIN * DM))[i] = (v4u){0u, 0u, 0u, 0u};
        { const float* wlw = IN_(7); const float* wla = IN_(9); const float* wlg = IN_(10); bf16* LoraT = WSP(bf16, WS_LORA);
          for (int i = gt; i < LORA_N * LORA_K; i += NGT) { const int n = i / LORA_K, k = i % LORA_K; float v = 0.f;
            if (n < 512) { if (k < 64) v = wlw[k * DR + n]; }
            else if (n < 1024) { if (k >= 64 && k < 128) v = wla[(k - 64) * DR + (n - 512)]; }
            else { if (k >= 128 && k < 288) v = wlg[(k - 128) * DR + (n - 1024)]; }
            LoraT[i] = (bf16)f2bf(v); } }
        { const float* x = IN_(0); bf16* XB = WSP(bf16, WS_XB); float* RSTDX = WSP(float, CTL_RSTDX);
          for (int m = gw; m < T; m += NGW) row_to_bf16_rstd(LANE, x + (size_t)m * DM, XB + (size_t)m * DM, RSTDX + m); }
        { const float* mem = IN_(1); bf16* MEMB = WSP(bf16, WS_MEMB); float* RSTDM = WSP(float, CTL_RSTDM);
          for (int m = gw; m < NB * NMEM; m += NGW) row_to_bf16_rstd(LANE, mem + (size_t)m * DM, MEMB + (size_t)m * DM, RSTDM + m); }
        { float* SSQ1 = WSP(float, CTL_SSQ1); float* SSQ2 = WSP(float, CTL_SSQ2); for (int i = gt; i < T; i += NGT) { SSQ1[i] = 0.f; SSQ2[i] = 0.f; } }
    }
    SEAM(0);
    if (IN(1)) {
        { PHASE_KA; pg8::Gemm g{WSP(bf16, WS_XB), WSP(bf16, WS_WIN), DM, DM, DM}; pg8::StaticOrder S; S.init(T, DINP, F.G, (int)blockIdx.x, DM, DM);
          EpiRoute E{WSP(bf16, WS_PRKV), WSP(bf16, WS_PCV), WSP(bf16, WS_PG), WSP(bf16, WS_PLI), WSP(float, CTL_RSTDX)}; pg8::gemm_phase(F.lds, F.wave, g, S, E); }
        { PHASE_KA; pg8::Gemm g{WSP(bf16, WS_MEMB), WSP(bf16, WS_WKV), DM, DM, DM}; pg8::StaticOrder S; S.init(NB * NMEM, DM, F.G, (int)((blockIdx.x + 128) % F.G), DM, DM);
          EpiRowBf16<0> E{WSP(bf16, WS_KMAT), DM, 256, WSP(float, CTL_RSTDM), 1.f}; pg8::gemm_phase(F.lds, F.wave, g, S, E); }
        { PHASE_KA; pg8::Gemm g{WSP(bf16, WS_WKV) + (size_t)DM * DM, WSP(bf16, WS_MEMB), DM, DM, DM}; pg8::StaticOrder S; S.init(DM, NB * NMEM, F.G, (int)((blockIdx.x + 120) % F.G), DM, DM);
          EpiRowBf16<3> E{WSP(bf16, WS_VT), NB * NMEM, 256, WSP(float, CTL_RSTDM), 1.f}; pg8::gemm_phase(F.lds, F.wave, g, S, E); }
    }
    SEAM(1);
    if (IN(2)) {
        PHASE_IDS; PHASE_KA;
        const float* mu = IN_(5); const float* conv_w = IN_(16);
        const bf16* PLI = WSP(bf16, WS_PLI); const bf16* PCV = WSP(bf16, WS_PCV); bf16* AP = WSP(bf16, WS_AP); bf16* OUTB = WSP(bf16, WS_OUTB);
        for (int t = gw; t < T; t += NGW) {
            const bool first = (t % SEQ) == 0;
            for (int c = LANE; c < LORA_K; c += 64) { float v = 0.f;
                if (c < 288) { const float p = bf2f(PLI[(size_t)t * 288 + c]); const float pv = first ? 0.f : bf2f(PLI[(size_t)(t - 1) * 288 + c]);
                    const float s = p + (pv - p) * mu[1536 + c];
                    v = (c < 64) ? tanhf(s) : (c < 128) ? s : sigmoidf_(s); }
                AP[(size_t)t * LORA_K + c] = (bf16)f2bf(v); }
            { const int c = LANE * 8, tl = t % SEQ; const bf16* p = PCV + (size_t)t * 1536;
              f32x4 b0, b1, c0, c1, x0, x1, u0a, u0b, u1a = (f32x4){0.f, 0.f, 0.f, 0.f}, u1b = u1a, u2a = u1a, u2b = u1a;
              unpack8(*(const u32x4*)(p + c), b0, b1); unpack8(*(const u32x4*)(p + 512 + c), c0, c1); unpack8(*(const u32x4*)(p + 1024 + c), x0, x1); u0a = c0 * x0; u0b = c1 * x1;
              if (tl >= 1) { unpack8(*(const u32x4*)(p - 1536 + 512 + c), c0, c1); unpack8(*(const u32x4*)(p - 1536 + 1024 + c), x0, x1); u1a = c0 * x0; u1b = c1 * x1; }
              if (tl >= 2) { unpack8(*(const u32x4*)(p - 3072 + 512 + c), c0, c1); unpack8(*(const u32x4*)(p - 3072 + 1024 + c), x0, x1); u2a = c0 * x0; u2b = c1 * x1; }
              const f32x4 w0a = *(const f32x4*)(conv_w + c), w0b = *(const f32x4*)(conv_w + c + 4), w1a = *(const f32x4*)(conv_w + 512 + c), w1b = *(const f32x4*)(conv_w + 512 + c + 4),
                          w2a = *(const f32x4*)(conv_w + 1024 + c), w2b = *(const f32x4*)(conv_w + 1024 + c + 4);
              const f32x4 ya = b0 * (w0a * u2a + w1a * u1a + w2a * u0a), yb = b1 * (w0b * u2b + w1b * u1b + w2b * u0b);
              *(u32x4*)(OUTB + (size_t)t * DR + c) = pack8(ya, yb); }
        }
    }
    SEAM(2);
    if (IN(3)) {
        PHASE_KA; pg8::Gemm g{WSP(bf16, WS_AP), WSP(bf16, WS_LORA), LORA_K, LORA_K, LORA_K}; pg8::StaticOrder S; S.init(T, LORA_N, F.G, (int)blockIdx.x, LORA_K, LORA_K);
        EpiLora E{WSP(float, WS_LW), WSP(bf16, WS_ALR), (bf16*)ka->out, IN_(6), IN_(8)}; pg8::gemm_phase(F.lds, F.wave, g, S, E);
    }
    SEAM(3);
    if (IN(4)) {
        if ((int)blockIdx.x < NB * NH) {
            PHASE_IDS; PHASE_KA;
            const float* mu = IN_(5); const float* k_k = IN_(11); const float* k_a = IN_(12); const float* r_k = IN_(13); const float* lnw = IN_(14); const float* lnb = IN_(15);
            const bf16* PRKV = WSP(bf16, WS_PRKV); const float* LW = WSP(float, WS_LW); const bf16* ALR = WSP(bf16, WS_ALR); const bf16* GG = (const bf16*)ka->out; bf16* OUTA = WSP(bf16, WS_OUTA);
            constexpr int GS = 16;
            LAS float* sr = (LAS float*)F.lds; LAS float* sw = sr + GS * 64; LAS float* sk = sw + GS * 64; LAS float* sa = sk + GS * 64; LAS float* sb = sa + GS * 64; LAS float* sv = sb + GS * 64; LAS float* sy = sv + GS * 64;
            const int b = blockIdx.x / NH, h = blockIdx.x % NH, tid = TID, row = tid >> 3, part = tid & 7;
            float S[8];
#pragma unroll
            for (int j = 0; j < 8; ++j) S[j] = 0.f;
            const int st_t = tid >> 5, st_j = (tid & 31) * 2;
            for (int g0 = 0; g0 < SEQ; g0 += GS) {
                const int t = b * SEQ + g0 + st_t; const bool first = (g0 + st_t) == 0;
                float nrm = 0.f, bon = 0.f, kkv[2], alr[2], vsh[2];
#pragma unroll
                for (int e = 0; e < 2; ++e) { const int j = st_j + e, col = h * HD + j;
                    const bf16* pr = PRKV + (size_t)t * 1536;
                    float rr = bf2f(pr[col]), kraw = bf2f(pr[512 + col]), vv = bf2f(pr[1024 + col]);
                    const float rp = first ? 0.f : bf2f(pr[-1536 + col]), kp = first ? 0.f : bf2f(pr[-1536 + 512 + col]), vp = first ? 0.f : bf2f(pr[-1536 + 1024 + col]);
                    rr += (rp - rr) * mu[col]; kraw += (kp - kraw) * mu[512 + col]; vv += (vp - vv) * mu[1024 + col];
                    const float zz = -LW[(size_t)t * DR + col]; const float sp = fmaxf(zz, 0.f) + __logf(1.f + __expf(-fabsf(zz)));
                    const float decay = __expf(-__expf(-sp - 0.5f));
                    alr[e] = sigmoidf_(bf2f(ALR[(size_t)t * DR + col]));
                    kkv[e] = kraw * k_k[col]; nrm += kkv[e] * kkv[e];
                    const float kmod = kraw * (1.f + (alr[e] - 1.f) * k_a[col]);
                    bon += rr * kmod * r_k[col]; vsh[e] = vv;
                    sr[st_t * 64 + j] = rr; sw[st_t * 64 + j] = decay; sk[st_t * 64 + j] = kmod; sv[st_t * 64 + j] = vv; }
#pragma unroll
                for (int o = 1; o < 32; o <<= 1) { nrm += __shfl_xor(nrm, o); bon += __shfl_xor(bon, o); }
                const float inv = 1.f / fmaxf(sqrtf(nrm), 1e-12f);
#pragma unroll
                for (int e = 0; e < 2; ++e) { const float kn = kkv[e] * inv; sa[st_t * 64 + st_j + e] = -kn; sb[st_t * 64 + st_j + e] = kn * alr[e]; }
                __syncthreads();
#pragma unroll 1
                for (int tt = 0; tt < GS; ++tt) {
                    float dot = 0.f;
#pragma unroll
                    for (int j = 0; j < 8; ++j) dot = fmaf(S[j], sa[tt * 64 + part * 8 + j], dot);
                    dot += __shfl_xor(dot, 1); dot += __shfl_xor(dot, 2); dot += __shfl_xor(dot, 4);
                    const float vv = sv[tt * 64 + row]; float y = 0.f;
#pragma unroll
                    for (int j = 0; j < 8; ++j) { const int kx = tt * 64 + part * 8 + j;
                        S[j] = fmaf(S[j], sw[kx], fmaf(dot, sb[kx], vv * sk[kx])); y = fmaf(S[j], sr[kx], y); }
                    y += __shfl_xor(y, 1); y += __shfl_xor(y, 2); y += __shfl_xor(y, 4);
                    if (part == 0) sy[tt * 64 + row] = y;
                }
                __syncthreads();
                {
                    const float y0 = sy[st_t * 64 + st_j], y1 = sy[st_t * 64 + st_j + 1];
                    float s = y0 + y1;
#pragma unroll
                    for (int o = 1; o < 32; o <<= 1) s += __shfl_xor(s, o);
                    const float mean = s * (1.f / 64.f); const float d0 = y0 - mean, d1 = y1 - mean; float q = d0 * d0 + d1 * d1;
#pragma unroll
                    for (int o = 1; o < 32; o <<= 1) q += __shfl_xor(q, o);
                    const float rs = rsqrtf(q * (1.f / 64.f) + LN_X_EPS); const int col = h * HD + st_j;
                    const float o0 = (d0 * rs * lnw[col] + lnb[col] + bon * vsh[0]) * bf2f(GG[(size_t)t * DR + col]);
                    const float o1 = (d1 * rs * lnw[col + 1] + lnb[col + 1] + bon * vsh[1]) * bf2f(GG[(size_t)t * DR + col + 1]);
                    *(unsigned*)(OUTA + (size_t)t * DR + col) = pk2(o0, o1);
                }
                __syncthreads();
            }
        }
    }
    SEAM(4);
    if (IN(5)) {
        { PHASE_KA; pg8::Gemm g{WSP(bf16, WS_OUTA), WSP(bf16, WS_WPA), DR, DR, DR}; pg8::StaticOrder S; S.init(T, DM, F.G, (int)blockIdx.x, DR, DR);
          EpiGate<0> E{WSP(bf16, WS_PG), 0, IN_(4), WSP(float, WS_MA), WSP(bf16, WS_MERGED)}; pg8::gemm_phase(F.lds, F.wave, g, S, E); }
        { PHASE_KA; pg8::Gemm g{WSP(bf16, WS_OUTB), WSP(bf16, WS_WPB), DR, DR, DR}; pg8::StaticOrder S; S.init(T, DM, F.G, (int)blockIdx.x, DR, DR);
          EpiGate<1> E{WSP(bf16, WS_PG), 1024, IN_(4) + DM, WSP(float, WS_MA), WSP(bf16, WS_MERGED)}; pg8::gemm_phase(F.lds, F.wave, g, S, E); }
    }
    SEAM(5);
    if (IN(6)) {
        PHASE_KA; pg8::Gemm g{WSP(bf16, WS_MERGED), WSP(bf16, WS_WOUT), DM, DM, DM}; pg8::StaticOrder S; S.init(T, DM, F.G, (int)blockIdx.x, DM, DM);
        EpiResid<1> E{IN_(0), ka->out, WSP(bf16, WS_XB1), WSP(float, CTL_SSQ1)}; pg8::gemm_phase(F.lds, F.wave, g, S, E);
    }
    SEAM(6);
    if (IN(7)) {
        PHASE_KA; pg8::Gemm g{WSP(bf16, WS_XB1), WSP(bf16, WS_WQ), DM, DM, DM}; pg8::StaticOrder S; S.init(T, DM, F.G, (int)blockIdx.x, DM, DM);
        EpiRowBf16<1> E{WSP(bf16, WS_Q), DM, 256, WSP(float, CTL_SSQ1), 0.0625f * 1.4426950408889634f}; pg8::gemm_phase(F.lds, F.wave, g, S, E);
    }
    SEAM(7);
    if (IN(8)) {
        PHASE_KA; pg8::Gemm g{WSP(bf16, WS_Q), WSP(bf16, WS_KMAT), DM, DM, XD}; pg8::AttnOrder S{F.G, (int)blockIdx.x, (size_t)NMEM * DM * 2, (size_t)XD * 2};
        EpiSoftmax E{WSP(bf16, WS_P)}; pg8::gemm_phase(F.lds, F.wave, g, S, E);
    }
    SEAM(8);
    if (IN(9)) {
        PHASE_KA; pg8::Gemm g{WSP(bf16, WS_P), WSP(bf16, WS_VT), DM, NB * NMEM, NMEM}; pg8::AttnOrder S{F.G, (int)blockIdx.x, (size_t)NMEM * 2, (size_t)XD * NB * NMEM * 2};
        EpiRowBf16<4> E{WSP(bf16, WS_O), DM, 256, nullptr, 1.f}; pg8::gemm_phase(F.lds, F.wave, g, S, E);
    }
    SEAM(9);
    if (IN(10)) {
        PHASE_KA; pg8::Gemm g{WSP(bf16, WS_O), WSP(bf16, WS_WXO), DM, DM, DM}; pg8::StaticOrder S; S.init(T, DM, F.G, (int)blockIdx.x, DM, DM);
        EpiResid<1> E{ka->out, ka->out, WSP(bf16, WS_XB2), WSP(float, CTL_SSQ2)}; pg8::gemm_phase(F.lds, F.wave, g, S, E);
    }
    SEAM(10);
    if (IN(11)) {
        PHASE_KA; pg8::Gemm g{WSP(bf16, WS_XB2), WSP(bf16, WS_WUP), DM, DM, DM}; pg8::StaticOrder S; S.init(T, DFF, F.G, (int)blockIdx.x, DM, DM);
        EpiRowBf16<2> E{WSP(bf16, WS_HID), DFF, 256, WSP(float, CTL_SSQ2), 1.f}; pg8::gemm_phase(F.lds, F.wave, g, S, E);
    }
    SEAM(11);
    if (IN(12)) {
        PHASE_KA; pg8::Gemm g{WSP(bf16, WS_HID), WSP(bf16, WS_WDN), DFF, DFF, DFF}; pg8::StaticOrder S; S.init(T, DM, F.G, (int)blockIdx.x, DFF, DFF);
        EpiResid<0> E{ka->out, ka->out, nullptr, nullptr}; pg8::gemm_phase(F.lds, F.wave, g, S, E);
    }
    SEAM(12);
    if (IN(13)) {
        PHASE_IDS; PHASE_KA; float* out = ka->out; const float* norm_final = IN_(28);
        for (int m = gw; m < T; m += NGW) {
            GAS f32x4* xr = (GAS f32x4*)(out + (size_t)m * DM) + LANE; f32x4 v[4]; float s = 0.f;
#pragma unroll
            for (int j = 0; j < 4; ++j) { v[j] = xr[64 * j]; s += (v[j].x * v[j].x + v[j].y * v[j].y) + (v[j].z * v[j].z + v[j].w * v[j].w); }
            const float r = rsqrtf(wave_sum(s) * (1.f / DM) + RMS_EPS);
#pragma unroll
            for (int j = 0; j < 4; ++j) xr[64 * j] = v[j] * r * ((const f32x4*)norm_final)[LANE + 64 * j];
        }
    }
#undef IN
#undef SEAM
}
#ifndef MK_N_LAUNCHES
#define MK_N_LAUNCHES 1
#endif
extern "C" void kernel_launch(void* const* d_in, const int* in_sizes, int n_in, void* d_out, int out_size, void* d_ws, size_t ws_size, hipStream_t stream) {
    static int grid = 0;
    if (grid == 0) {
        if (n_in != 29 || in_sizes[0] != T * DM || out_size != T * DM || ws_size < WS_END) { fprintf(stderr, "kernel_launch: unexpected shapes (n_in %d, ws %zu)\n", n_in, ws_size); grid = -1; return; }
        int dev = 0, cus = 0, per_cu = 0;
        if (hipGetDevice(&dev) != hipSuccess || hipDeviceGetAttribute(&cus, hipDeviceAttributeMultiprocessorCount, dev) != hipSuccess) { grid = -1; return; }
        if (hipFuncSetAttribute((const void*)mk_fwd, hipFuncAttributeMaxDynamicSharedMemorySize, LDS_BYTES) != hipSuccess) { fprintf(stderr, "kernel_launch: hipFuncSetAttribute failed\n"); grid = -1; return; }
        if (hipOccupancyMaxActiveBlocksPerMultiprocessor(&per_cu, (const void*)mk_fwd, NWAVES * 64, LDS_BYTES) != hipSuccess || per_cu < 1) fprintf(stderr, "kernel_launch: occupancy query reports %d\n", per_cu);
        (void)hipGetLastError();
        grid = cus;
        if (grid != 256) fprintf(stderr, "kernel_launch: note: %d CUs\n", grid);
    }
    if (grid < 0) return;
    if (hipMemsetAsync((char*)d_ws + WS_CTL, 0, 64 * 1024, stream) != hipSuccess) { fprintf(stderr, "kernel_launch: memset failed\n"); return; }
    Args a{};
    for (int i = 0; i < 29; ++i) a.in[i] = (const float*)d_in[i];
    a.out = (float*)d_out; a.ws = (unsigned char*)d_ws;
    if (MK_N_LAUNCHES == 1) { a.ph_lo = 0; a.ph_hi = N_PHASES; hipLaunchKernelGGL(mk_fwd, dim3(grid), dim3(NWAVES * 64), LDS_BYTES, stream, a); }
    else for (int p = 0; p < N_PHASES; ++p) { a.ph_lo = p; a.ph_hi = p + 1; hipLaunchKernelGGL(mk_fwd, dim3(grid), dim3(NWAVES * 64), LDS_BYTES, stream, a); }
}
```

```cpp
#include <hip/hip_runtime.h>
#include <cstdio>
#include <cstdint>

__device__ __forceinline__ int lane_id_v() { int l; asm volatile("v_mbcnt_lo_u32_b32 %0, -1, 0\n\tv_mbcnt_hi_u32_b32 %0, -1, %0" : "=v"(l)); return l; }
namespace pg8 {
#define PG8_LAS __attribute__((address_space(3)))
typedef unsigned short bf16_t;
typedef short bf16x8 __attribute__((ext_vector_type(8)));
typedef float f32x4 __attribute__((ext_vector_type(4)));
typedef unsigned u32x4 __attribute__((ext_vector_type(4)));
constexpr int BM = 256, BK = 64, HALF = 128, HTB = HALF * BK * 2, STAGE_BYTES = 8 * HTB, NXCD = 8, WGM = 8;

__host__ __device__ __forceinline__ int lds_byte(int r, int c) { const int st = (r >> 4) * 2 + (c >> 5), rr = r & 15, cc = c & 31, ob = rr * 64 + cc * 2; return st * 1024 + (ob ^ (((ob >> 9) & 1) << 5)); }
__host__ __device__ __forceinline__ void stage_rc(int b, int& R, int& C) { const int st = b / 1024, sb = b % 1024, swz = sb ^ (((sb >> 9) & 1) << 5); R = (st >> 1) * 16 + swz / 64; C = (st & 1) * 32 + (swz % 64) / 2; }
__host__ __device__ __forceinline__ int perm32(int rho) { const int n = rho >> 4, i = rho & 15; return 8 * (i >> 2) + 4 * n + (i & 3); }

struct Unit { int pm, pn; unsigned aoff, boff; };
struct Gemm { const bf16_t* A; const bf16_t* Bt; int lda, ldb, K; };

struct StaticOrder {
    int nM, nN, nwg, G, c, lda, ldb;
    __device__ void init(int M, int N, int G_, int c_, int lda_, int ldb_) { nM = M / BM; nN = N / BM; nwg = nM * nN; G = G_; c = c_; lda = lda_; ldb = ldb_; }
    __device__ bool next(int i, Unit& u) const {
        const long L = (long)i * G + c; if (L >= nwg) return false;
        int wgid = (int)L; { const int q = nwg / NXCD, r = nwg % NXCD, xcd = wgid % NXCD, off = wgid / NXCD; wgid = (xcd < r ? xcd * (q + 1) : r * (q + 1) + (xcd - r) * q) + off; }
        const int nig = WGM * nN, gid = wgid / nig, fm = gid * WGM, gsz = (nM - fm) < WGM ? (nM - fm) : WGM;
        u.pm = fm + ((wgid % nig) % gsz); u.pn = (wgid % nig) / gsz;
        u.aoff = (unsigned)u.pm * BM * lda * 2u; u.boff = (unsigned)u.pn * BM * ldb * 2u; return true;
    }
};
struct AttnOrder {
    int G, c; unsigned bstride_b, bstride_h;
    __device__ bool next(int i, Unit& u) const {
        const int L = i * G + c; if (L >= 256) return false;
        u.pm = L >> 2; u.pn = L & 3;
        u.aoff = ((unsigned)u.pm * BM * 1024u + u.pn * 256u) * 2u; u.boff = (unsigned)(u.pm >> 5) * bstride_b + (unsigned)u.pn * bstride_h; return true;
    }
};

typedef float f32x2_t __attribute__((ext_vector_type(2))); typedef __bf16 bf16x2_t __attribute__((ext_vector_type(2)));
__device__ __forceinline__ unsigned cvt_pk_bf16(float lo, float hi) { f32x2_t v = {lo, hi}; bf16x2_t b = __builtin_convertvector(v, bf16x2_t); return __builtin_bit_cast(unsigned, b); }

template <class Epi, class Sched>
__device__ __forceinline__ void gemm_phase(PG8_LAS unsigned char* lds, const int wid, const Gemm g, const Sched& S, const Epi& E) {
    const int lane = lane_id_v(), tid = wid * 64 + lane, wr = wid >> 2, wc = wid & 3, fr = lane & 15, fq = lane >> 4;
    const int K = g.K, nt = K / BK;
    unsigned voffA[2], voffB[2];
#pragma unroll
    for (int i = 0; i < 2; ++i) { int R, C; stage_rc(tid * 16 + i * 8192, R, C); const int Rb = (R & ~31) + perm32(R & 31);
        voffA[i] = (unsigned)(R * g.lda + C) * 2u; voffB[i] = (unsigned)(Rb * g.ldb + C) * 2u; }
    const unsigned kstep = (unsigned)(BK * 2);
    const unsigned hA = (unsigned)HALF * g.lda * 2u, hB = (unsigned)HALF * g.ldb * 2u;
    const __amdgpu_buffer_rsrc_t rA = __builtin_amdgcn_make_buffer_rsrc((void*)g.A, (short)0, 0x7fffffff, 0x00020000);
    const __amdgpu_buffer_rsrc_t rB = __builtin_amdgcn_make_buffer_rsrc((void*)g.Bt, (short)0, 0x7fffffff, 0x00020000);
    const unsigned ldsw = (unsigned)wid * 1024u;
    const int aoff = lds_byte(wr * 64 + fr, fq * 8), boff = lds_byte(wc * 32 + fr, fq * 8);
#define PG8_SA(b, h) (((b) * 2 + (h)) * HTB)
#define PG8_SB(b, h) ((4 + (b) * 2 + (h)) * HTB)
#define PG8_STAGE_(bufoff, rsrc, soff, voff) do { _Pragma("unroll") for (int _i = 0; _i < 2; ++_i) \
        __builtin_amdgcn_raw_ptr_buffer_load_lds(rsrc, (PG8_LAS unsigned*)(lds + (bufoff) + ldsw + _i * 8192), 16, (voff)[_i], (soff), 0, 0); } while (0)
#define PG8_STAGEA(bufoff, soff) PG8_STAGE_(bufoff, rA, soff, voffA)
#define PG8_STAGEB(bufoff, soff) PG8_STAGE_(bufoff, rB, soff, voffB)
#define PG8_LDA(dst, b, h) do { _Pragma("unroll") for (int m = 0; m < 4; ++m) _Pragma("unroll") for (int k = 0; k < 2; ++k) dst[m][k] = *(const PG8_LAS bf16x8*)(lds + PG8_SA(b, h) + aoff + m * 2048 + k * 1024); } while (0)
#define PG8_LDB(dst, b, h) do { _Pragma("unroll") for (int n = 0; n < 2; ++n) _Pragma("unroll") for (int k = 0; k < 2; ++k) dst[n][k] = *(const PG8_LAS bf16x8*)(lds + PG8_SB(b, h) + boff + n * 2048 + k * 1024); } while (0)
#define PG8_MMA(ai, bj, At, Bt) do { __builtin_amdgcn_s_setprio(1); _Pragma("unroll") for (int m = 0; m < 4; ++m) _Pragma("unroll") for (int n = 0; n < 2; ++n) _Pragma("unroll") for (int k = 0; k < 2; ++k) \
        acc[ai][bj][m][n] = __builtin_amdgcn_mfma_f32_16x16x32_bf16(Bt[n][k], At[m][k], acc[ai][bj][m][n], 0, 0, 0); __builtin_amdgcn_s_setprio(0); } while (0)
#define PG8_WAIT_V(n) asm volatile("s_waitcnt vmcnt(" #n ")" ::: "memory")
#define PG8_WAIT_L(n) asm volatile("s_waitcnt lgkmcnt(" #n ")" ::: "memory")
#define PG8_BAR __builtin_amdgcn_s_barrier()
#define PG8_SCHED __builtin_amdgcn_sched_barrier(0)
    Unit cur, nxt; int ui = 0;
    if (!S.next(0, cur)) return;
    f32x4 acc[2][2][4][2];
#pragma unroll
    for (int a = 0; a < 2; ++a)
#pragma unroll
        for (int b = 0; b < 2; ++b)
#pragma unroll
            for (int m = 0; m < 4; ++m)
#pragma unroll
                for (int n = 0; n < 2; ++n) acc[a][b][m][n] = (f32x4){0.f, 0.f, 0.f, 0.f};
    bf16x8 At[4][2], B0[2][2], B1[2][2];
    unsigned cA = cur.aoff, cB = cur.boff;
    PG8_STAGEB(PG8_SB(0, 0), cB); PG8_STAGEB(PG8_SB(0, 1), cB + hB); PG8_STAGEA(PG8_SA(0, 0), cA); PG8_STAGEA(PG8_SA(0, 1), cA + hA);
    if (wr == 1) PG8_BAR;
    PG8_WAIT_V(2); PG8_BAR;
    PG8_STAGEB(PG8_SB(1, 0), cB + kstep); PG8_STAGEA(PG8_SA(1, 0), cA + kstep); PG8_STAGEB(PG8_SB(1, 1), cB + hB + kstep);
    PG8_WAIT_V(6); PG8_BAR;
    for (;;) {
        const bool has_next = S.next(ui + 1, nxt);
        const unsigned nA = has_next ? nxt.aoff : cA, nB = has_next ? nxt.boff : cB;
        for (int t = 0; t < nt; t += 2) {
            const bool last = (t == nt - 2);
            const unsigned a1 = cA + (unsigned)(t + 1) * kstep;
            const unsigned a2 = last ? nA : cA + (unsigned)(t + 2) * kstep, b2 = last ? nB : cB + (unsigned)(t + 2) * kstep;
            const unsigned a3 = a2 + kstep, b3 = b2 + kstep;
            PG8_LDB(B0, 0, 0); PG8_LDB(B1, 0, 1); PG8_SCHED; PG8_LDA(At, 0, 0); PG8_STAGEA(PG8_SA(1, 1), a1 + hA);
            PG8_WAIT_V(8); PG8_WAIT_L(0); PG8_BAR; PG8_MMA(0, 0, At, B0); PG8_MMA(0, 1, At, B1); PG8_BAR; PG8_SCHED;
            PG8_LDA(At, 0, 1); PG8_STAGEB(PG8_SB(0, 0), b2); PG8_STAGEB(PG8_SB(0, 1), b2 + hB); PG8_STAGEA(PG8_SA(0, 0), a2);
            PG8_WAIT_V(8); PG8_WAIT_L(0); PG8_BAR; PG8_MMA(1, 0, At, B0); PG8_MMA(1, 1, At, B1); PG8_BAR; PG8_SCHED;
            PG8_LDB(B0, 1, 0); PG8_LDB(B1, 1, 1); PG8_SCHED; PG8_LDA(At, 1, 0); PG8_STAGEA(PG8_SA(0, 1), a2 + hA);
            PG8_WAIT_V(8); PG8_WAIT_L(0); PG8_BAR; PG8_MMA(0, 0, At, B0); PG8_MMA(0, 1, At, B1); PG8_BAR; PG8_SCHED;
            PG8_LDA(At, 1, 1); PG8_STAGEB(PG8_SB(1, 0), b3); PG8_STAGEB(PG8_SB(1, 1), b3 + hB); PG8_STAGEA(PG8_SA(1, 0), a3);
            PG8_WAIT_V(8); PG8_WAIT_L(0); PG8_BAR; PG8_MMA(1, 0, At, B0); PG8_MMA(1, 1, At, B1); PG8_BAR; PG8_SCHED;
        }
        if constexpr (!Epi::AFTER_DRAIN) { if (wr == 0) PG8_BAR; const int l2 = lane_id_v(), fr2 = l2 & 15, fq2 = l2 >> 4;
            E(acc, cur, wr, wc, fr2, fq2); }
        if (!has_next) break;
#pragma unroll
        for (int a = 0; a < 2; ++a)
#pragma unroll
            for (int b = 0; b < 2; ++b)
#pragma unroll
                for (int m = 0; m < 4; ++m)
#pragma unroll
                    for (int n = 0; n < 2; ++n) acc[a][b][m][n] = (f32x4){0.f, 0.f, 0.f, 0.f};
        cur = nxt; cA = nA; cB = nB; ++ui;
        if constexpr (!Epi::AFTER_DRAIN) { if (wr == 1) PG8_BAR; }
    }
    PG8_WAIT_V(0);
    if constexpr (Epi::AFTER_DRAIN) { if (wr == 0) PG8_BAR; }
    PG8_BAR;
    if constexpr (Epi::AFTER_DRAIN) { const int l2 = lane_id_v(), fr2 = l2 & 15, fq2 = l2 >> 4; E.fused(acc, cur, wr, wc, fr2, fq2, lds, wid, l2); }
#undef PG8_SA
#undef PG8_SB
#undef PG8_STAGE_
#undef PG8_STAGEA
#undef PG8_STAGEB
#undef PG8_LDA
#undef PG8_LDB
#undef PG8_MMA
#undef PG8_WAIT_V
#undef PG8_WAIT_L
#undef PG8_BAR
#undef PG8_SCHED
}
}

constexpr int NB = 2, SEQ = 8192, DM = 1024, T = NB * SEQ;
constexpr int DR = 512, NH = 8, HD = 64, RWC = 1824, DIN = 5408, DINP = 5632;
constexpr int NMEM = 256, XH = 4, XD = 256, DFF = 4096, LORA_K = 384, LORA_N = 1536;
constexpr float RMS_EPS = 1e-6f, LN_X_EPS = 64e-5f;
constexpr int NWAVES = 8;

constexpr size_t MiB = 1u << 20;
constexpr size_t WS_CTL = 0, CTL_ZERO_BYTES = 1 * MiB;
constexpr size_t WS_WIN = 2 * MiB;
constexpr size_t WS_WPA = 13 * MiB, WS_WPB = 14 * MiB, WS_WOUT = 15 * MiB, WS_WQ = 17 * MiB, WS_WKV = 19 * MiB, WS_WXO = 23 * MiB;
constexpr size_t WS_WUP = 25 * MiB, WS_WDN = 33 * MiB, WS_LORA = 41 * MiB;
constexpr size_t WS_MEMB = 43 * MiB;
constexpr size_t WS_KMAT = 44 * MiB;
constexpr size_t WS_VT = 45 * MiB;
constexpr size_t WS_XB = 48 * MiB;
constexpr size_t WS_AP = WS_XB, WS_OUTA = WS_XB, WS_OUTB = WS_XB + 16 * MiB;
constexpr size_t WS_PRKV = 80 * MiB;
constexpr size_t WS_PCV = 128 * MiB;
constexpr size_t WS_LW = WS_PCV, WS_ALR = WS_PCV + 32 * MiB;
constexpr size_t WS_PG = 176 * MiB;
constexpr size_t WS_PLI = 240 * MiB;
constexpr size_t WS_MA = 80 * MiB;
constexpr size_t WS_MERGED = 144 * MiB;
constexpr size_t WS_XB1 = 48 * MiB;
constexpr size_t WS_Q = 80 * MiB;
constexpr size_t WS_P = 112 * MiB;
constexpr size_t WS_O = 144 * MiB;
constexpr size_t WS_XB2 = 48 * MiB;
constexpr size_t WS_HID = 80 * MiB;
constexpr size_t WS_END = 256 * MiB;
constexpr int CW_BAR = 4096;
constexpr size_t DO_R2 = 16 * MiB, DO_Y2 = 32 * MiB, DO_AG = 48 * MiB, DO_BG = 50 * MiB, DO_XG = 52 * MiB;
constexpr size_t CTL_BON = 384 * 1024;
constexpr int NCH = SEQ / 64, NGRP = 16, GCH = 8;
constexpr size_t CTL_RSTDX = 64 * 1024, CTL_RSTDM = 128 * 1024, CTL_SSQ1 = 192 * 1024, CTL_SSQ2 = 256 * 1024;

constexpr int RING_BYTES = 131072, LDS_BYTES = 147456, LDSCTL_OFF = LDS_BYTES - 512, MISC_OFF = LDSCTL_OFF + 320;

#define GAS __attribute__((address_space(1)))
#define LAS __attribute__((address_space(3)))
typedef unsigned short bf16;
typedef unsigned v4u __attribute__((ext_vector_type(4)));
typedef float f32x4 __attribute__((ext_vector_type(4)));
typedef GAS unsigned gu32;
#define RLX_AGENT __ATOMIC_RELAXED, __HIP_MEMORY_SCOPE_AGENT
#define LDS_WAIT() asm volatile("s_waitcnt lgkmcnt(0)" ::: "memory")
__device__ __forceinline__ unsigned f2bf(float f) { unsigned u = __builtin_bit_cast(unsigned, f); return (u + 0x7fffu + ((u >> 16) & 1u)) >> 16; }
__device__ __forceinline__ unsigned pk2(float lo, float hi) { return f2bf(lo) | (f2bf(hi) << 16); }
__device__ __forceinline__ float bf2f(unsigned short h) { return __builtin_bit_cast(float, (unsigned)h << 16); }
__device__ __forceinline__ float bflo(unsigned w) { return __builtin_bit_cast(float, w << 16); }
__device__ __forceinline__ float bfhi(unsigned w) { return __builtin_bit_cast(float, w & 0xffff0000u); }
__device__ __forceinline__ float sigmoidf_(float x) { return 1.f / (1.f + __expf(-x)); }
__device__ __forceinline__ float wave_sum(float v) {
#pragma unroll
    for (int o = 1; o < 64; o <<= 1) v += __shfl_xor(v, o);
    return v;
}

#define XB_TMO      128
#define XB_XCNT(j)  (256  + 64 * (j))
#define XB_XSUB(j)  (1280 + 64 * (j))
#define XB_XGEN(j)  (2304 + 64 * (j))
#define XB_TOP      3328
#define XB_TOPGEN   3392
#define XCD_BAR_WORDS 3456
#define XB_SPIN_CAP (1u << 20)
__device__ __forceinline__ unsigned xb_ld(unsigned* p)              { return __hip_atomic_load(p, __ATOMIC_RELAXED, __HIP_MEMORY_SCOPE_AGENT); }
__device__ __forceinline__ unsigned xb_add(unsigned* p, unsigned v) { return __hip_atomic_fetch_add(p, v, __ATOMIC_RELAXED, __HIP_MEMORY_SCOPE_AGENT); }
__device__ __forceinline__ unsigned xb_xcc_id() { return (unsigned)__builtin_amdgcn_s_getreg((3 << 11) | 20) & 0xFu; }
#define XB_SPIN(cond, bar) do { unsigned _sp = 0; while (cond) { __builtin_amdgcn_s_sleep(1); \
    if ((++_sp & 255u) == 0u) { if (xb_ld(&(bar)[XB_TMO])) break; if (_sp > XB_SPIN_CAP) { atomicAdd(&(bar)[XB_TMO], 1u); break; } } } } while (0)
struct XcdBarrier { unsigned* bar; unsigned x; volatile LAS unsigned* st; };
__device__ __forceinline__ XcdBarrier xcd_barrier_post(unsigned* bar, volatile LAS unsigned* st) {
    XcdBarrier b; b.bar = bar; b.x = xb_xcc_id(); b.st = st;
    if (threadIdx.x == 0) (void)xb_add(&bar[XB_XCNT(b.x)], 1u);
    return b;
}
__device__ __forceinline__ void xcd_barrier_complete(unsigned* bar, unsigned x, unsigned& nloc, unsigned& nx) {
    const unsigned G = gridDim.x * gridDim.y * gridDim.z;
    unsigned sum, cnt, mine, sp = 0u;
    for (;;) {
        sum = 0u; cnt = 0u; mine = 0u;
#pragma unroll
        for (unsigned j = 0; j < 16; ++j) { const unsigned c = xb_ld(&bar[XB_XCNT(j)]); sum += c; cnt += (c > 0u) ? 1u : 0u; mine = (j == x) ? c : mine; }
        if (sum == G) break;
        __builtin_amdgcn_s_sleep(1);
        if ((++sp & 255u) == 0u) { if (xb_ld(&bar[XB_TMO])) break; if (sp > XB_SPIN_CAP) { atomicAdd(&bar[XB_TMO], 1u); break; } }
    }
    nloc = mine > 0u ? mine : 1u; nx = cnt > 0u ? cnt : 1u;
}
__device__ __forceinline__ void xcd_barrier(const XcdBarrier& b, const int wave) {
    asm volatile("s_waitcnt vmcnt(0)" ::: "memory");
    __syncthreads();
    if (wave == 0 && lane_id_v() == 0) {
        unsigned* bar = b.bar;
        __builtin_amdgcn_s_waitcnt(0);
        unsigned nloc = b.st[0], nx = b.st[1];
        if (nloc == 0u) { xcd_barrier_complete(bar, b.x, nloc, nx); b.st[0] = nloc; b.st[1] = nx; }
        const unsigned old = xb_add(&bar[XB_XSUB(b.x)], 1u);
        const unsigned gen = old / nloc;
        if (old + 1u == (gen + 1u) * nloc) {
            __builtin_amdgcn_fence(__ATOMIC_RELEASE, "agent");
            asm volatile("s_waitcnt vmcnt(0)" ::: "memory");
            const unsigned og = xb_add(&bar[XB_TOP], 1u);
            const unsigned tg = og / nx;
            if (og + 1u == (tg + 1u) * nx) xb_add(&bar[XB_TOPGEN], 1u);
            else XB_SPIN(xb_ld(&bar[XB_TOPGEN]) == tg, bar);
            __builtin_amdgcn_fence(__ATOMIC_ACQUIRE, "agent");
            xb_add(&bar[XB_XGEN(b.x)], 1u);
            asm volatile("s_waitcnt vmcnt(0)" ::: "memory");
        } else {
            XB_SPIN(xb_ld(&bar[XB_XGEN(b.x)]) == gen, bar);
            __builtin_amdgcn_fence(__ATOMIC_ACQUIRE, "agent");
            asm volatile("s_waitcnt vmcnt(0)" ::: "memory");
        }
    }
    __syncthreads();
}

using pg8::f32x4; using pg8::u32x4; using pg8::Unit; using pg8::cvt_pk_bf16;
#define EPI_ROWS(ai, m) (u.pm * 256 + (ai) * 128 + wr * 64 + (m) * 16 + fr)
#define EPI_CL(bj) ((bj) * 128 + wc * 32 + 8 * fq)
__device__ __forceinline__ u32x4 pack8(f32x4 v0, f32x4 v1) { u32x4 w; w.x = cvt_pk_bf16(v0[0], v0[1]); w.y = cvt_pk_bf16(v0[2], v0[3]); w.z = cvt_pk_bf16(v1[0], v1[1]); w.w = cvt_pk_bf16(v1[2], v1[3]); return w; }
__device__ __forceinline__ void unpack8(u32x4 w, f32x4& v0, f32x4& v1) { v0 = (f32x4){bflo(w.x), bfhi(w.x), bflo(w.y), bfhi(w.y)}; v1 = (f32x4){bflo(w.z), bfhi(w.z), bflo(w.w), bfhi(w.w)}; }

struct EpiRoute {
    static constexpr bool AFTER_DRAIN = false;
    bf16 *prkv, *pcv, *pg, *pli; const float* rstd;
    __device__ __forceinline__ void operator()(const f32x4 (&acc)[2][2][4][2], const Unit& u, int wr, int wc, int fr, int fq) const {
        bf16* base; int ld, c0, lim;
        if (u.pn < 6) { base = prkv; ld = 1536; c0 = u.pn * 256; lim = 1536; }
        else if (u.pn < 12) { base = pcv; ld = 1536; c0 = (u.pn - 6) * 256; lim = 1536; }
        else if (u.pn < 20) { base = pg; ld = 2048; c0 = (u.pn - 12) * 256; lim = 2048; }
        else { base = pli; ld = 288; c0 = (u.pn - 20) * 256; lim = 288; }
#pragma unroll
        for (int ai = 0; ai < 2; ++ai)
#pragma unroll
            for (int m = 0; m < 4; ++m) { const int row = EPI_ROWS(ai, m); const float s = rstd[row];
#pragma unroll
                for (int bj = 0; bj < 2; ++bj) { const int c = c0 + EPI_CL(bj);
                    if (c < lim) *(u32x4*)(base + (size_t)row * ld + c) = pack8(acc[ai][bj][m][0] * s, acc[ai][bj][m][1] * s); } }
    }
};
struct EpiLora {
    static constexpr bool AFTER_DRAIN = false;
    float* lw; bf16* alr; bf16* g; const float* w0; const float* a0;
    __device__ __forceinline__ void operator()(const f32x4 (&acc)[2][2][4][2], const Unit& u, int wr, int wc, int fr, int fq) const {
        const int kind = u.pn >> 1, cb = (u.pn & 1) * 256;
#pragma unroll
        for (int bj = 0; bj < 2; ++bj) { const int c = cb + EPI_CL(bj);
            f32x4 b0 = (f32x4){0.f, 0.f, 0.f, 0.f}, b1 = b0;
            if (kind == 0) { b0 = *(const f32x4*)(w0 + c); b1 = *(const f32x4*)(w0 + c + 4); }
            if (kind == 1) { b0 = *(const f32x4*)(a0 + c); b1 = *(const f32x4*)(a0 + c + 4); }
#pragma unroll
            for (int ai = 0; ai < 2; ++ai)
#pragma unroll
                for (int m = 0; m < 4; ++m) { const int row = EPI_ROWS(ai, m);
                    f32x4 v0 = acc[ai][bj][m][0] + b0, v1 = acc[ai][bj][m][1] + b1;
                    if (kind == 0) { float* p = lw + (size_t)row * DR + c; *(f32x4*)p = v0; *(f32x4*)(p + 4) = v1; }
                    else if (kind == 1) *(u32x4*)(alr + (size_t)row * DR + c) = pack8(v0, v1);
                    else *(u32x4*)(g + (size_t)row * DR + c) = pack8(v0, v1);
                } }
    }
};
template <int SECOND> struct EpiGate {
    static constexpr bool AFTER_DRAIN = false;
    const bf16* pg; int goff; const float* bias; float* ma; bf16* merged;
    __device__ __forceinline__ void operator()(const f32x4 (&acc)[2][2][4][2], const Unit& u, int wr, int wc, int fr, int fq) const {
#pragma unroll
        for (int bj = 0; bj < 2; ++bj) { const int c = u.pn * 256 + EPI_CL(bj);
            const f32x4 b0 = *(const f32x4*)(bias + c), b1 = *(const f32x4*)(bias + c + 4);
#pragma unroll
            for (int ai = 0; ai < 2; ++ai)
#pragma unroll
                for (int m = 0; m < 4; ++m) { const int row = EPI_ROWS(ai, m);
                    f32x4 g0, g1; unpack8(*(const u32x4*)(pg + (size_t)row * 2048 + goff + c), g0, g1);
                    f32x4 v0 = acc[ai][bj][m][0], v1 = acc[ai][bj][m][1];
#pragma unroll
                    for (int e = 0; e < 4; ++e) { v0[e] *= sigmoidf_(g0[e] + b0[e]); v1[e] *= sigmoidf_(g1[e] + b1[e]); }
                    float* p = ma + (size_t)row * DM + c;
                    if (SECOND) { v0 += *(const f32x4*)p; v1 += *(const f32x4*)(p + 4); *(u32x4*)(merged + (size_t)row * DM + c) = pack8(v0, v1); }
                    else { *(f32x4*)p = v0; *(f32x4*)(p + 4) = v1; }
                } }
    }
};
template <int WITH_XB> struct EpiResid {
    static constexpr bool AFTER_DRAIN = false;
    const float* R; float* out; bf16* xb; float* ssq;
    __device__ __forceinline__ void operator()(const f32x4 (&acc)[2][2][4][2], const Unit& u, int wr, int wc, int fr, int fq) const {
#pragma unroll
        for (int ai = 0; ai < 2; ++ai)
#pragma unroll
            for (int m = 0; m < 4; ++m) { const int row = EPI_ROWS(ai, m); float s = 0.f;
#pragma unroll
                for (int bj = 0; bj < 2; ++bj) { const size_t off = (size_t)row * DM + u.pn * 256 + EPI_CL(bj);
                    const f32x4 v0 = acc[ai][bj][m][0] + *(const f32x4*)(R + off), v1 = acc[ai][bj][m][1] + *(const f32x4*)(R + off + 4);
                    *(f32x4*)(out + off) = v0; *(f32x4*)(out + off + 4) = v1;
                    if (WITH_XB) { *(u32x4*)(xb + off) = pack8(v0, v1);
                        s += (v0[0] * v0[0] + v0[1] * v0[1]) + (v0[2] * v0[2] + v0[3] * v0[3]) + (v1[0] * v1[0] + v1[1] * v1[1]) + (v1[2] * v1[2] + v1[3] * v1[3]); } }
                if (WITH_XB) { s += __shfl_xor(s, 16); s += __shfl_xor(s, 32); if (fq == 0) atomicAdd(ssq + row, s); } }
    }
};
template <int MODE> struct EpiRowBf16 {
    static constexpr bool AFTER_DRAIN = false;
    bf16* out; int ldc; int coloff_mul; const float* rs; float scale;
    __device__ __forceinline__ void operator()(const f32x4 (&acc)[2][2][4][2], const Unit& u, int wr, int wc, int fr, int fq) const {
#pragma unroll
        for (int ai = 0; ai < 2; ++ai)
#pragma unroll
            for (int m = 0; m < 4; ++m) { const int row = EPI_ROWS(ai, m);
                float s = 1.f;
                if (MODE == 0) s = rs[row];
                if (MODE == 1 || MODE == 2) s = rsqrtf(rs[row] * (1.f / DM) + RMS_EPS) * scale;
#pragma unroll
                for (int bj = 0; bj < 2; ++bj) { const int c = u.pn * coloff_mul + EPI_CL(bj);
                    f32x4 v0 = acc[ai][bj][m][0] * s, v1 = acc[ai][bj][m][1] * s;
                    if (MODE == 2) {
#pragma unroll
                        for (int e = 0; e < 4; ++e) { v0[e] = fmaxf(v0[e], 0.f); v0[e] *= v0[e]; v1[e] = fmaxf(v1[e], 0.f); v1[e] *= v1[e]; } }
                    if (MODE == 3) { v0 *= *(const f32x4*)(rs + c); v1 *= *(const f32x4*)(rs + c + 4); }
                    *(u32x4*)(out + (size_t)row * ldc + c) = pack8(v0, v1); } }
    }
};
struct EpiSoftmax {
    static constexpr bool AFTER_DRAIN = true;
    bf16* P;
    __device__ __forceinline__ void fused(f32x4 (&acc)[2][2][4][2], const Unit& u, int wr, int wc, int fr, int fq, LAS unsigned char* lds, int wid, int lane) const {
        LAS float* X = (LAS float*)lds;
        LAS float* Y = (LAS float*)(lds + 4096);
#pragma unroll
        for (int ai = 0; ai < 2; ++ai)
#pragma unroll
            for (int m = 0; m < 4; ++m) { float mx = -3.0e38f;
#pragma unroll
                for (int bj = 0; bj < 2; ++bj)
#pragma unroll
                    for (int n = 0; n < 2; ++n) { const f32x4 v = acc[ai][bj][m][n]; mx = fmaxf(fmaxf(mx, fmaxf(v[0], v[1])), fmaxf(v[2], v[3])); }
                mx = fmaxf(mx, __shfl_xor(mx, 16)); mx = fmaxf(mx, __shfl_xor(mx, 32));
                if (fq == 0) X[(ai * 128 + wr * 64 + m * 16 + fr) * 4 + wc] = mx; }
        LDS_WAIT(); __builtin_amdgcn_s_barrier(); asm volatile("" ::: "memory");
#pragma unroll
        for (int ai = 0; ai < 2; ++ai)
#pragma unroll
            for (int m = 0; m < 4; ++m) { const int r = ai * 128 + wr * 64 + m * 16 + fr;
                const f32x4 q = *(const LAS f32x4*)(X + r * 4); const float mx = fmaxf(fmaxf(q[0], q[1]), fmaxf(q[2], q[3])); float s = 0.f;
#pragma unroll
                for (int bj = 0; bj < 2; ++bj)
#pragma unroll
                    for (int n = 0; n < 2; ++n) {
#pragma unroll
                        for (int e = 0; e < 4; ++e) { const float p = __builtin_amdgcn_exp2f(acc[ai][bj][m][n][e] - mx); acc[ai][bj][m][n][e] = p; s += p; } }
                s += __shfl_xor(s, 16); s += __shfl_xor(s, 32);
                if (fq == 0) Y[r * 4 + wc] = s; }
        LDS_WAIT(); __builtin_amdgcn_s_barrier(); asm volatile("" ::: "memory");
#pragma unroll
        for (int ai = 0; ai < 2; ++ai)
#pragma unroll
            for (int m = 0; m < 4; ++m) { const int r = ai * 128 + wr * 64 + m * 16 + fr;
                const f32x4 q = *(const LAS f32x4*)(Y + r * 4); const float inv = 1.f / ((q[0] + q[1]) + (q[2] + q[3]));
#pragma unroll
                for (int bj = 0; bj < 2; ++bj)
                    *(u32x4*)(P + (size_t)(u.pm * 256 + r) * DM + u.pn * 256 + EPI_CL(bj)) = pack8(acc[ai][bj][m][0] * inv, acc[ai][bj][m][1] * inv); }
        LDS_WAIT(); __builtin_amdgcn_s_barrier(); asm volatile("" ::: "memory");
    }
};


namespace wkv {
typedef short bf16x8 __attribute__((ext_vector_type(8)));
typedef float f32x16 __attribute__((ext_vector_type(16)));
typedef unsigned u32x2 __attribute__((ext_vector_type(2)));
constexpr int MB = 9216, PITCH = 144;
constexpr int L_AT = 0, L_RT = MB, L_BT = 2 * MB, L_KT = 3 * MB, L_BHT = 4 * MB, L_KHT = 5 * MB, L_VT = 6 * MB, L_AAK = 7 * MB, L_ARB = 8 * MB, L_ARK = 9 * MB;
constexpr int L_WT = L_BT, L_ULT = L_KT, L_PT = L_AT, L_RH = L_AAK;
constexpr int L_AABM = 10 * MB, L_RED = L_AABM, L_RHSU = L_AABM + MB, L_AABD = L_RHSU + MB, L_ZT = L_AABD + 4096, L_EGL = L_ZT + 10240, L_ACT = L_EGL + 256, L_BCT = L_ACT + MB, L_END = L_BCT + MB;
constexpr int L_TP = L_AAK, P32 = 80;
static_assert(L_END <= LDSCTL_OFF, "WKV LDS map");
__device__ __forceinline__ f32x4 tile_mm(LAS const unsigned char* L, int xoff, int xrow0, int yoff, int yrow0, int fr, int fq, f32x4 acc) {
#pragma unroll
    for (int ks = 0; ks < 2; ++ks) {
        const bf16x8 xf = *(const LAS bf16x8*)(L + xoff + (xrow0 + fr) * PITCH + ks * 64 + fq * 16);
        const bf16x8 yf = *(const LAS bf16x8*)(L + yoff + (yrow0 + fr) * PITCH + ks * 64 + fq * 16);
        acc = __builtin_amdgcn_mfma_f32_16x16x32_bf16(yf, xf, acc, 0, 0, 0);
    }
    return acc;
}
__device__ __forceinline__ u32x2 pack4(f32x4 v) { u32x2 w; w.x = cvt_pk_bf16(v[0], v[1]); w.y = cvt_pk_bf16(v[2], v[3]); return w; }
__device__ __forceinline__ f32x4 unpack4(u32x2 w) { return (f32x4){bflo(w.x), bfhi(w.x), bflo(w.y), bfhi(w.y)}; }
__device__ __forceinline__ int perm16(int x) { return 8 * ((x >> 2) & 1) + 4 * (x >> 3) + (x & 3); }

__device__ __forceinline__ f32x4 tile_mm32(LAS const unsigned char* L, int xoff, int xrow0, int yoff, int yrow0, int fr, int fq) {
    const bf16x8 xf = *(const LAS bf16x8*)(L + xoff + (xrow0 + fr) * P32 + fq * 16);
    const bf16x8 yf = *(const LAS bf16x8*)(L + yoff + (yrow0 + fr) * P32 + fq * 16);
    return __builtin_amdgcn_mfma_f32_16x16x32_bf16(yf, xf, (f32x4){0.f, 0.f, 0.f, 0.f}, 0, 0, 0);
}
struct ChunkIn { const bf16* prkv; const float* lw; const bf16* alr; const float* mu; const float* k_k; const float* k_a; const float* r_k; float* bon; bf16* r2; bf16* y2; bf16* ag; bf16* bg; };

__device__ __forceinline__ void group_phase(LAS unsigned char* L, const int wave, const int grp, const ChunkIn& I) {
    const int lane = lane_id_v(), fr = lane & 15, fq = lane >> 4;
    const int bh = grp >> 4, g = grp & 15, b = bh >> 3, h = bh & 7;
    const int k8 = wave * 8, col = h * HD + k8;
    for (int i = wave * 64 + lane; i < 64 * 64; i += 512) { const int r = i >> 6, c = i & 63;
        *(LAS unsigned short*)(L + L_ACT + r * PITCH + c * 2) = (r == c) ? (unsigned short)0x3f80 : (unsigned short)0;
        *(LAS unsigned short*)(L + L_BCT + r * PITCH + c * 2) = 0; }
    for (int i = wave * 64 + lane; i < 10240 / 4; i += 512) *(LAS unsigned*)(L + L_ZT + i * 4) = 0u;
#pragma unroll 1
    for (int ci = 0; ci < GCH; ++ci) {
        float mur[8], muk[8], muv[8], ckk[8], cka[8], crk[8];
#pragma unroll
        for (int e = 0; e < 8; ++e) { mur[e] = I.mu[col + e]; muk[e] = I.mu[512 + col + e]; muv[e] = I.mu[1024 + col + e]; ckk[e] = I.k_k[col + e]; cka[e] = I.k_a[col + e]; crk[e] = I.r_k[col + e]; }
        const int c = g * GCH + ci, t = b * SEQ + c * 64 + lane; const bool first = (c == 0) && (lane == 0);
        const size_t cid = (size_t)(bh * NCH + c);
        float rr[8], km[8], vv[8], lw[8], av[8], bv[8];
        {
            const bf16* pr = I.prkv + (size_t)t * 1536 + col;
            f32x4 a0, a1, p0, p1; const u32x4 z4 = (u32x4){0u, 0u, 0u, 0u};
            unpack8(*(const u32x4*)pr, a0, a1); unpack8(first ? z4 : *(const u32x4*)(pr - 1536), p0, p1);
#pragma unroll
            for (int e = 0; e < 4; ++e) { rr[e] = a0[e] + (p0[e] - a0[e]) * mur[e]; rr[4 + e] = a1[e] + (p1[e] - a1[e]) * mur[4 + e]; }
            unpack8(*(const u32x4*)(pr + 512), a0, a1); unpack8(first ? z4 : *(const u32x4*)(pr - 1536 + 512), p0, p1);
            float kr[8];
#pragma unroll
            for (int e = 0; e < 4; ++e) { kr[e] = a0[e] + (p0[e] - a0[e]) * muk[e]; kr[4 + e] = a1[e] + (p1[e] - a1[e]) * muk[4 + e]; }
            unpack8(*(const u32x4*)(pr + 1024), a0, a1); unpack8(first ? z4 : *(const u32x4*)(pr - 1536 + 1024), p0, p1);
#pragma unroll
            for (int e = 0; e < 4; ++e) { vv[e] = a0[e] + (p0[e] - a0[e]) * muv[e]; vv[4 + e] = a1[e] + (p1[e] - a1[e]) * muv[4 + e]; }
            const f32x4 l0 = *(const f32x4*)(I.lw + (size_t)t * DR + col), l1 = *(const f32x4*)(I.lw + (size_t)t * DR + col + 4);
            f32x4 q0, q1; unpack8(*(const u32x4*)(I.alr + (size_t)t * DR + col), q0, q1);
            float nrm = 0.f, bon = 0.f, alr[8], kkv[8];
#pragma unroll
            for (int e = 0; e < 8; ++e) {
                const float zz = -(e < 4 ? l0[e & 3] : l1[e & 3]); const float sp = fmaxf(zz, 0.f) + __logf(1.f + __expf(-fabsf(zz)));
                lw[e] = -__expf(-sp - 0.5f);
                alr[e] = sigmoidf_(e < 4 ? q0[e & 3] : q1[e & 3]);
                kkv[e] = kr[e] * ckk[e]; nrm += kkv[e] * kkv[e];
                km[e] = kr[e] * (1.f + (alr[e] - 1.f) * cka[e]);
                bon += rr[e] * km[e] * crk[e];
            }
            LAS float* red = (LAS float*)(L + L_RED);
            red[wave * 64 + lane] = nrm; red[512 + wave * 64 + lane] = bon;
            LDS_WAIT(); __builtin_amdgcn_s_barrier(); asm volatile("" ::: "memory");
            nrm = 0.f; bon = 0.f;
#pragma unroll
            for (int w2 = 0; w2 < 8; ++w2) { nrm += red[w2 * 64 + lane]; bon += red[512 + w2 * 64 + lane]; }
            const float inv = 1.f / fmaxf(sqrtf(nrm), 1e-12f);
            if (wave == 0) I.bon[(size_t)t * NH + h] = bon;
#pragma unroll
            for (int e = 0; e < 8; ++e) { const float kn = kkv[e] * inv; av[e] = -kn; bv[e] = kn * alr[e]; }
        }
        {
            u32x4 wat, wrt, wbt, wkt; unsigned short bh_[8], kh_[8];
            float cat[8], crt[8], cbt[8], ckt[8];
#pragma unroll
            for (int e = 0; e < 8; ++e) {
                float cum = lw[e];
#pragma unroll
                for (int o = 1; o < 64; o <<= 1) { const float y = __shfl_up(cum, o); if (lane >= o) cum += y; }
                const float gl = __shfl(cum, 63);
                const float E = __expf(cum), Ei = __expf(-cum), Ep = __expf(cum - lw[e]), Eg = __expf(gl - cum);
                cat[e] = av[e] * Ep; crt[e] = rr[e] * E; cbt[e] = bv[e] * Ei; ckt[e] = km[e] * Ei;
                bh_[e] = (unsigned short)f2bf(bv[e] * Eg); kh_[e] = (unsigned short)f2bf(km[e] * Eg);
                if (lane == 63) *(LAS float*)(L + L_EGL + (k8 + e) * 4) = __expf(gl);
            }
            wat = pack8((f32x4){cat[0], cat[1], cat[2], cat[3]}, (f32x4){cat[4], cat[5], cat[6], cat[7]});
            wrt = pack8((f32x4){crt[0], crt[1], crt[2], crt[3]}, (f32x4){crt[4], crt[5], crt[6], crt[7]});
            wbt = pack8((f32x4){cbt[0], cbt[1], cbt[2], cbt[3]}, (f32x4){cbt[4], cbt[5], cbt[6], cbt[7]});
            wkt = pack8((f32x4){ckt[0], ckt[1], ckt[2], ckt[3]}, (f32x4){ckt[4], ckt[5], ckt[6], ckt[7]});
            *(LAS u32x4*)(L + L_AT + lane * PITCH + k8 * 2) = wat; *(LAS u32x4*)(L + L_RT + lane * PITCH + k8 * 2) = wrt;
            *(LAS u32x4*)(L + L_BT + lane * PITCH + k8 * 2) = wbt; *(LAS u32x4*)(L + L_KT + lane * PITCH + k8 * 2) = wkt;
#pragma unroll
            for (int e = 0; e < 8; ++e) { *(LAS unsigned short*)(L + L_BHT + (k8 + e) * PITCH + lane * 2) = bh_[e]; *(LAS unsigned short*)(L + L_KHT + (k8 + e) * PITCH + lane * 2) = kh_[e];
                *(LAS unsigned short*)(L + L_VT + (k8 + e) * PITCH + lane * 2) = (unsigned short)f2bf(vv[e]); }
        }
        LDS_WAIT(); __builtin_amdgcn_s_barrier(); asm volatile("" ::: "memory");
        {
            const int p = wave >> 1, half = wave & 1;
            const int xoff = (p < 2) ? L_AT : L_RT, yoff = (p & 1) ? L_KT : L_BT, moff = (p == 0) ? L_AABM : (p == 1) ? L_AAK : (p == 2) ? L_ARB : L_ARK;
#pragma unroll 1
            for (int rbi = 0; rbi < 2; ++rbi) { const int rb = half ? (1 + rbi) : (rbi ? 3 : 0);
#pragma unroll 1
                for (int cb = 0; cb < 4; ++cb) { const int tt = rb * 16 + fr, s0 = cb * 16 + 4 * fq;
                    f32x4 acc = (f32x4){0.f, 0.f, 0.f, 0.f};
                    if (cb <= rb) acc = tile_mm(L, xoff, rb * 16, yoff, cb * 16, fr, fq, acc);
                    if (p == 0) { if (cb == rb) { *(LAS f32x4*)(L + L_AABD + (rb * 256 + fr * 16 + 4 * fq) * 4) = acc; acc = (f32x4){0.f, 0.f, 0.f, 0.f}; } }
                    else {
#pragma unroll
                        for (int e = 0; e < 4; ++e) { const int ss = s0 + e; const bool keep = (p == 1) ? (ss < tt) : (ss <= tt); acc[e] = keep ? acc[e] : 0.f; } }
                    *(LAS u32x2*)(L + moff + tt * PITCH + s0 * 2) = pack4(acc); } }
        }
        LDS_WAIT(); __builtin_amdgcn_s_barrier(); asm volatile("" ::: "memory");
        {
            const int rb = wave >> 1;
#pragma unroll
            for (int cbi = 0; cbi < 2; ++cbi) { const int cb = 2 * (wave & 1) + cbi;
                const f32x4 acc = tile_mm(L, L_AAK, rb * 16, L_VT, cb * 16, fr, fq, (f32x4){0.f, 0.f, 0.f, 0.f});
                *(LAS u32x2*)(L + L_RHSU + (rb * 16 + fr) * PITCH + (cb * 16 + 4 * fq) * 2) = pack4(acc); }
        }
        LDS_WAIT(); __builtin_amdgcn_s_barrier(); asm volatile("" ::: "memory");
        if (wave == 0) {
            const int bi = lane >> 4, cc = lane & 15; float z[16];
#pragma unroll
            for (int r = 0; r < 16; ++r) { float acc = (r == cc) ? 1.f : 0.f;
#pragma unroll
                for (int s4 = 0; s4 < 4; ++s4) { if (4 * s4 >= r) continue; const f32x4 a = *(const LAS f32x4*)(L + L_AABD + (bi * 256 + r * 16 + 4 * s4) * 4);
                    if (4 * s4 + 0 < r) acc = fmaf(a[0], z[4 * s4 + 0], acc);
                    if (4 * s4 + 1 < r) acc = fmaf(a[1], z[4 * s4 + 1], acc);
                    if (4 * s4 + 2 < r) acc = fmaf(a[2], z[4 * s4 + 2], acc);
                    if (4 * s4 + 3 < r) acc = fmaf(a[3], z[4 * s4 + 3], acc); }
                z[r] = acc;
                *(LAS unsigned short*)(L + L_TP + (bi * 16 + r) * P32 + cc * 2) = (unsigned short)f2bf(acc);
                *(LAS unsigned short*)(L + L_TP + (bi * 16 + r) * P32 + (16 + cc) * 2) = 0; }
        }
        LDS_WAIT(); __builtin_amdgcn_s_barrier(); asm volatile("" ::: "memory");
        {
            const int xt = (wave < 4) ? L_WT : L_ULT, rsrc = (wave < 4) ? L_AT : L_RHSU, cb16 = (wave & 3) * 16;
#pragma unroll 1
            for (int bi = 0; bi < 4; ++bi) {
                f32x4 acc = (f32x4){0.f, 0.f, 0.f, 0.f};
                if (bi > 0) acc = tile_mm(L, xt, cb16, L_AABM, bi * 16, fr, fq, acc);
#pragma unroll
                for (int e = 0; e < 4; ++e) acc[e] += bf2f(*(const LAS unsigned short*)(L + rsrc + (bi * 16 + 4 * fq + e) * PITCH + (cb16 + fr) * 2));
                *(LAS u32x2*)(L + L_ZT + (wave * 16 + fr) * P32 + (4 * fq) * 2) = pack4(acc);
                LDS_WAIT(); __builtin_amdgcn_s_barrier(); asm volatile("" ::: "memory");
                const f32x4 xr = tile_mm32(L, L_ZT, wave * 16, L_TP, bi * 16, fr, fq);
                *(LAS u32x2*)(L + xt + (cb16 + fr) * PITCH + (bi * 16 + 4 * fq) * 2) = pack4(xr);
                LDS_WAIT(); __builtin_amdgcn_s_barrier(); asm volatile("" ::: "memory");
            }
        }
        const int o = wave >> 1, rb0 = 2 * (wave & 1);
        f32x4 res[2][4];
        {
            const int x1 = (o == 0) ? L_BHT : (o == 1) ? L_ULT : L_ARB, y1 = (o == 0) ? L_WT : (o == 1) ? L_BHT : (o == 2) ? L_WT : L_ULT;
            const int x2 = (o == 1) ? L_VT : L_ARK, y2 = (o == 1) ? L_KHT : L_VT;
#pragma unroll
            for (int ri = 0; ri < 2; ++ri)
#pragma unroll
                for (int cb = 0; cb < 4; ++cb) { f32x4 acc = tile_mm(L, x1, (rb0 + ri) * 16, y1, cb * 16, fr, fq, (f32x4){0.f, 0.f, 0.f, 0.f});
                    if (o & 1) acc = tile_mm(L, x2, (rb0 + ri) * 16, y2, cb * 16, fr, fq, acc);
                    res[ri][cb] = acc; }
            if (o == 0) {
#pragma unroll
                for (int ri = 0; ri < 2; ++ri)
#pragma unroll
                    for (int cb = 0; cb < 4; ++cb) { const int ko = (rb0 + ri) * 16 + fr, ki = cb * 16 + 4 * fq; const float eg = *(const LAS float*)(L + L_EGL + ko * 4);
#pragma unroll
                        for (int e = 0; e < 4; ++e) if (ki + e == ko) res[ri][cb][e] += eg;
                        *(LAS u32x2*)(L + L_PT + ko * PITCH + ki * 2) = pack4(res[ri][cb]); }
            }
            if (o == 2) {
#pragma unroll
                for (int ri = 0; ri < 2; ++ri)
#pragma unroll
                    for (int cb = 0; cb < 4; ++cb) { const int tt = (rb0 + ri) * 16 + fr, kk = cb * 16 + 4 * fq;
                        res[ri][cb] += unpack4(*(const LAS u32x2*)(L + L_RT + tt * PITCH + kk * 2));
                        *(LAS u32x2*)(L + L_RH + tt * PITCH + kk * 2) = pack4(res[ri][cb]); }
            }
        }
        LDS_WAIT(); __builtin_amdgcn_s_barrier(); asm volatile("" ::: "memory");
        {
            const int xo = (o == 0) ? L_ACT : (o == 1) ? L_BCT : L_RH, yo = (o < 2) ? L_PT : (o == 2) ? L_ACT : L_BCT;
#pragma unroll
            for (int ri = 0; ri < 2; ++ri)
#pragma unroll
                for (int cb = 0; cb < 4; ++cb) { const f32x4 init = (o & 1) ? res[ri][cb] : (f32x4){0.f, 0.f, 0.f, 0.f};
                    res[ri][cb] = tile_mm(L, xo, (rb0 + ri) * 16, yo, cb * 16, fr, fq, init); }
            if (o >= 2) { bf16* dst = ((o == 2) ? I.r2 : I.y2) + cid * 4096;
#pragma unroll
                for (int ri = 0; ri < 2; ++ri)
#pragma unroll
                    for (int cb = 0; cb < 4; ++cb) *(u32x2*)(dst + ((rb0 + ri) * 16 + fr) * 64 + cb * 16 + 4 * fq) = pack4(res[ri][cb]); }
        }
        LDS_WAIT(); __builtin_amdgcn_s_barrier(); asm volatile("" ::: "memory");
        if (o < 2) { const int dsto = (o == 0) ? L_ACT : L_BCT;
#pragma unroll
            for (int ri = 0; ri < 2; ++ri)
#pragma unroll
                for (int cb = 0; cb < 4; ++cb) *(LAS u32x2*)(L + dsto + ((rb0 + ri) * 16 + fr) * PITCH + (cb * 16 + 4 * fq) * 2) = pack4(res[ri][cb]); }
    }
    LDS_WAIT(); __builtin_amdgcn_s_barrier(); asm volatile("" ::: "memory");
    for (int i = wave * 64 + lane; i < 64 * 64; i += 512) { const int k0 = i >> 6, ko = i & 63;
        I.ag[(size_t)grp * 4096 + ko * 64 + 16 * (k0 >> 4) + perm16(k0 & 15)] = *(const LAS unsigned short*)(L + L_ACT + k0 * PITCH + ko * 2);
        I.bg[(size_t)grp * 4096 + i] = *(const LAS unsigned short*)(L + L_BCT + (i >> 6) * PITCH + (i & 63) * 2); }
    LDS_WAIT(); __builtin_amdgcn_s_barrier(); asm volatile("" ::: "memory");
}

__device__ __forceinline__ void chain_phase(const int bh, const int vs, const bf16* AG, const bf16* BG, bf16* XG) {
    const int lane = lane_id_v(), c32 = lane & 31, hh = lane >> 5, v = 32 * vs + c32;
    f32x16 X[2];
#pragma unroll
    for (int r = 0; r < 16; ++r) { X[0][r] = 0.f; X[1][r] = 0.f; }
#pragma unroll 1
    for (int g = 0; g < NGRP; ++g) {
        const bf16* ag = AG + (size_t)(bh * NGRP + g) * 4096; const bf16* bg = BG + (size_t)(bh * NGRP + g) * 4096; bf16* xg = XG + (size_t)(bh * NGRP + g) * 4096;
        bf16x8 af[2][2][2]; u32x2 bq[2][4];
#pragma unroll
        for (int i = 0; i < 2; ++i)
#pragma unroll
            for (int j = 0; j < 2; ++j)
#pragma unroll
                for (int s = 0; s < 2; ++s) af[i][j][s] = *(const bf16x8*)(ag + (32 * i + c32) * 64 + 32 * j + 16 * s + 8 * hh);
#pragma unroll
        for (int i = 0; i < 2; ++i)
#pragma unroll
            for (int q = 0; q < 4; ++q) bq[i][q] = *(const u32x2*)(bg + v * 64 + 32 * i + 8 * q + 4 * hh);
        unsigned px[2][8];
#pragma unroll
        for (int j = 0; j < 2; ++j)
#pragma unroll
            for (int q = 0; q < 4; ++q) { px[j][2 * q] = cvt_pk_bf16(X[j][4 * q], X[j][4 * q + 1]); px[j][2 * q + 1] = cvt_pk_bf16(X[j][4 * q + 2], X[j][4 * q + 3]);
                *(u32x2*)(xg + v * 64 + 32 * j + 8 * q + 4 * hh) = (u32x2){px[j][2 * q], px[j][2 * q + 1]}; }
        f32x16 Xn[2];
#pragma unroll
        for (int i = 0; i < 2; ++i)
#pragma unroll
            for (int q = 0; q < 4; ++q) { const f32x4 t4 = unpack4(bq[i][q]); Xn[i][4 * q] = t4[0]; Xn[i][4 * q + 1] = t4[1]; Xn[i][4 * q + 2] = t4[2]; Xn[i][4 * q + 3] = t4[3]; }
#pragma unroll
        for (int i = 0; i < 2; ++i)
#pragma unroll
            for (int j = 0; j < 2; ++j)
#pragma unroll
                for (int s = 0; s < 2; ++s) { const u32x4 xw = (u32x4){px[j][4 * s], px[j][4 * s + 1], px[j][4 * s + 2], px[j][4 * s + 3]};
                    Xn[i] = __builtin_amdgcn_mfma_f32_32x32x16_bf16(af[i][j][s], __builtin_bit_cast(bf16x8, xw), Xn[i], 0, 0, 0); }
        X[0] = Xn[0]; X[1] = Xn[1];
    }
}

struct OutIn { const bf16* r2; const bf16* y2; const bf16* xg; const bf16* prkv; const float* mu; const float* bon; const bf16* g; const float* lnw; const float* lnb; bf16* outa; };
__device__ __forceinline__ void out_task(const int task, const OutIn& I) {
    const int lane = lane_id_v(), fr = lane & 15, fq = lane >> 4;
    const int cid = task >> 2, rb = task & 3, bh = cid / NCH, c = cid % NCH, b = bh >> 3, h = bh & 7, grp = bh * NGRP + (c >> 3);
    const int tl = c * 64 + rb * 16 + fr, t = b * SEQ + tl;
    const bf16* r2 = I.r2 + (size_t)cid * 4096 + (rb * 16 + fr) * 64; const bf16* xg = I.xg + (size_t)grp * 4096; const bf16* y2 = I.y2 + (size_t)cid * 4096 + (rb * 16 + fr) * 64;
    const bf16x8 xf0 = *(const bf16x8*)(r2 + fq * 8), xf1 = *(const bf16x8*)(r2 + 32 + fq * 8);
    f32x4 acc[4];
#pragma unroll
    for (int cb = 0; cb < 4; ++cb) { const bf16* yr = xg + (cb * 16 + fr) * 64;
        const bf16x8 yf0 = *(const bf16x8*)(yr + fq * 8), yf1 = *(const bf16x8*)(yr + 32 + fq * 8);
        acc[cb] = unpack4(*(const u32x2*)(y2 + cb * 16 + 4 * fq));
        acc[cb] = __builtin_amdgcn_mfma_f32_16x16x32_bf16(yf0, xf0, acc[cb], 0, 0, 0);
        acc[cb] = __builtin_amdgcn_mfma_f32_16x16x32_bf16(yf1, xf1, acc[cb], 0, 0, 0); }
    float s = 0.f;
#pragma unroll
    for (int cb = 0; cb < 4; ++cb) s += (acc[cb][0] + acc[cb][1]) + (acc[cb][2] + acc[cb][3]);
    s += __shfl_xor(s, 16); s += __shfl_xor(s, 32);
    const float mean = s * (1.f / 64.f); float q = 0.f;
#pragma unroll
    for (int cb = 0; cb < 4; ++cb) { acc[cb] = acc[cb] - mean; q += (acc[cb][0] * acc[cb][0] + acc[cb][1] * acc[cb][1]) + (acc[cb][2] * acc[cb][2] + acc[cb][3] * acc[cb][3]); }
    q += __shfl_xor(q, 16); q += __shfl_xor(q, 32);
    const float rs = rsqrtf(q * (1.f / 64.f) + LN_X_EPS), bon = I.bon[(size_t)t * NH + h];
#pragma unroll
    for (int cb = 0; cb < 4; ++cb) { const int colh = h * HD + cb * 16 + 4 * fq;
        const f32x4 vc = unpack4(*(const u32x2*)(I.prkv + (size_t)t * 1536 + 1024 + colh));
        const f32x4 vp = (tl == 0) ? (f32x4){0.f, 0.f, 0.f, 0.f} : unpack4(*(const u32x2*)(I.prkv + (size_t)(t - 1) * 1536 + 1024 + colh));
        const f32x4 vvv = vc + (vp - vc) * *(const f32x4*)(I.mu + 1024 + colh);
        const f32x4 gg = unpack4(*(const u32x2*)(I.g + (size_t)t * DR + colh));
        const f32x4 o4 = (acc[cb] * rs * *(const f32x4*)(I.lnw + colh) + *(const f32x4*)(I.lnb + colh) + vvv * bon) * gg;
        *(u32x2*)(I.outa + (size_t)t * DR + colh) = pack4(o4); }
}
}

struct Frame {
    LAS unsigned char* lds; volatile LAS unsigned* MISC;
    int wave, vcu, G;
};

__device__ __forceinline__ void p0_transpose_item(const float* W, int ldn, int ncols, int K, const float* kscale, bf16* WT, int row_off, LAS float* scr, int item, int lane) {
    const int nblk = ncols / 32, kb = item / nblk, nb = item % nblk, k0 = 64 * kb, n0 = 32 * nb;
#pragma unroll 8
    for (int i = 0; i < 32; ++i) { const int kk = 2 * i + (lane >> 5); float w = W[(size_t)(k0 + kk) * ldn + n0 + (lane & 31)]; if (kscale) w *= kscale[k0 + kk]; scr[kk * 33 + (lane & 31)] = w; }
    LDS_WAIT(); asm volatile("" ::: "memory");
    const int c = lane & 7;
#pragma unroll
    for (int j = 0; j < 4; ++j) { const int n = (lane >> 3) + 8 * j; const LAS float* s = scr + (8 * c) * 33 + n;
        v4u o; o.x = pk2(s[0 * 33], s[1 * 33]); o.y = pk2(s[2 * 33], s[3 * 33]); o.z = pk2(s[4 * 33], s[5 * 33]); o.w = pk2(s[6 * 33], s[7 * 33]);
        *(GAS v4u*)(WT + (size_t)(row_off + n0 + n) * K + k0 + 8 * c) = o; }
    LDS_WAIT(); asm volatile("" ::: "memory");
}
__device__ __forceinline__ void row_to_bf16_rstd(int lane, const float* xrow, bf16* orow, float* rstd_out) {
    const GAS f32x4* xr = (const GAS f32x4*)xrow + lane;
    f32x4 v[4]; float s = 0.f;
#pragma unroll
    for (int j = 0; j < 4; ++j) { v[j] = xr[64 * j]; s += (v[j].x * v[j].x + v[j].y * v[j].y) + (v[j].z * v[j].z + v[j].w * v[j].w); }
    const float r = rsqrtf(wave_sum(s) * (1.f / DM) + RMS_EPS);
    GAS unsigned long long* o8 = (GAS unsigned long long*)orow + lane;
#pragma unroll
    for (int j = 0; j < 4; ++j) o8[64 * j] = (unsigned long long)pk2(v[j].x, v[j].y) | ((unsigned long long)pk2(v[j].z, v[j].w) << 32);
    if (lane == 0) *rstd_out = r;
}

struct Args { const float* in[29]; float* out; unsigned char* ws; int ph_lo, ph_hi; };
constexpr int N_PHASES = 16;
typedef const Args __attribute__((address_space(4)))* KArgsP;
__device__ __forceinline__ KArgsP kargs() { KArgsP p = (KArgsP)__builtin_amdgcn_kernarg_segment_ptr(); asm volatile("" : "+s"(p)); return p; }
#define IN_(i) ((const float*)ka->in[i])
#define WSP(T_, off) ((T_*)(ws + (off)))

__global__ void __launch_bounds__(NWAVES * 64, 2) mk_fwd(Args args_unused) {
    extern __shared__ __attribute__((aligned(16))) unsigned char lds[];
    Frame F;
    F.lds = (LAS unsigned char*)lds;
    F.MISC = (volatile LAS unsigned*)(F.lds + MISC_OFF);
    F.wave = __builtin_amdgcn_readfirstlane((int)threadIdx.x >> 6);
    F.G = gridDim.x; { const int bx = blockIdx.x; F.vcu = (F.G % 8 == 0) ? (bx % 8) * (F.G / 8) + bx / 8 : bx; }
    for (int u = threadIdx.x; u < (LDS_BYTES - LDSCTL_OFF) / 4; u += NWAVES * 64) ((LAS unsigned*)(F.lds + LDSCTL_OFF))[u] = 0u;
    __syncthreads();
    int lo, hi; { KArgsP ka = kargs(); lo = ka->ph_lo; hi = ka->ph_hi; }
    const bool use_bar = (hi - lo) > 1;
    if (use_bar) { KArgsP ka = kargs(); (void)xcd_barrier_post((unsigned*)(ka->ws + WS_CTL) + CW_BAR, F.MISC + 8); }
#define IN(k) (lo <= (k) && (k) < hi)
#define SEAM(k) do { if (IN(k) && IN((k) + 1)) { KArgsP ka_ = kargs(); XcdBarrier b_; b_.bar = (unsigned*)(ka_->ws + WS_CTL) + CW_BAR; b_.x = xb_xcc_id(); b_.st = F.MISC + 8; xcd_barrier(b_, F.wave); } } while (0)
    const int gw = F.vcu * NWAVES + F.wave, NGW = F.G * NWAVES;
    const int NGT = F.G * NWAVES * 64;
#define PHASE_IDS const int LANE = lane_id_v(), TID = F.wave * 64 + LANE, gt = blockIdx.x * (NWAVES * 64) + TID; (void)gt; (void)TID
#define PHASE_KA KArgsP ka = kargs(); unsigned char* ws = ka->ws; (void)ws

    if (IN(0)) {
        PHASE_IDS; PHASE_KA;
        LAS float* scr = (LAS float*)(F.lds + F.wave * 16384);
        constexpr int I0 = 16 * 48, I1 = 16 * 112, I2 = 16 * 9, IPA = 8 * 32, IOUT = 16 * 32, IKV = 16 * 64, IUP = 16 * 128, IDN = 64 * 32;
        constexpr int NITEMS = I0 + I1 + I2 + 2 * IPA + 3 * IOUT + IKV + IUP + IDN;
        bf16* WinT = WSP(bf16, WS_WIN);
        for (int it = gw; it < NITEMS; it += NGW) {
            int r = it;
            if (r < I0) { p0_transpose_item(IN_(3), DIN, 1536, DM, IN_(2), WinT, 0, scr, r, LANE); continue; } r -= I0;
            if (r < I1) { p0_transpose_item(IN_(3) + 1824, DIN, 3584, DM, IN_(2), WinT, 1536, scr, r, LANE); continue; } r -= I1;
            if (r < I2) { p0_transpose_item(IN_(3) + 1536, DIN, 288, DM, IN_(2), WinT, 5120, scr, r, LANE); continue; } r -= I2;
            if (r < IPA) { p0_transpose_item(IN_(17), DM, DM, DR, nullptr, WSP(bf16, WS_WPA), 0, scr, r, LANE); continue; } r -= IPA;
            if (r < IPA) { p0_transpose_item(IN_(18), DM, DM, DR, nullptr, WSP(bf16, WS_WPB), 0, scr, r, LANE); continue; } r -= IPA;
            if (r < IOUT) { p0_transpose_item(IN_(19), DM, DM, DM, nullptr, WSP(bf16, WS_WOUT), 0, scr, r, LANE); continue; } r -= IOUT;
            if (r < IOUT) { p0_transpose_item(IN_(22), DM, DM, DM, IN_(20), WSP(bf16, WS_WQ), 0, scr, r, LANE); continue; } r -= IOUT;
            if (r < IOUT) { p0_transpose_item(IN_(24), DM, DM, DM, nullptr, WSP(bf16, WS_WXO), 0, scr, r, LANE); continue; } r -= IOUT;
            if (r < IKV) { p0_transpose_item(IN_(23), 2048, 2048, DM, IN_(21), WSP(bf16, WS_WKV), 0, scr, r, LANE); continue; } r -= IKV;
            if (r < IUP) { p0_transpose_item(IN_(26), DFF, DFF, DM, IN_(25), WSP(bf16, WS_WUP), 0, scr, r, LANE); continue; } r -= IUP;
            p0_transpose_item(IN_(27), DM, DM, DFF, nullptr, WSP(bf16, WS_WDN), 0, scr, r, LANE);
        }
        for (int i = gt; i < 224 * 1024 / 8; i += NGT) ((v4u*)(WinT + (size_t)DIN * DM))[i] = (v4u){0u, 0u, 0u, 0u};
        { const float* wlw = IN_(7); const float* wla = IN_(9); const float* wlg = IN_(10); bf16* LoraT = WSP(bf16, WS_LORA);
          for (int i = gt; i < LORA_N * LORA_K; i += NGT) { const int n = i / LORA_K, k = i % LORA_K; float v = 0.f;
            if (n < 512) { if (k < 64) v = wlw[k * DR + n]; }
            else if (n < 1024) { if (k >= 64 && k < 128) v = wla[(k - 64) * DR + (n - 512)]; }
            else { if (k >= 128 && k < 288) v = wlg[(k - 128) * DR + (n - 1024)]; }
            LoraT[i] = (bf16)f2bf(v); } }
        { const float* x = IN_(0); bf16* XB = WSP(bf16, WS_XB); float* RSTDX = WSP(float, CTL_RSTDX);
          for (int m = gw; m < T; m += NGW) row_to_bf16_rstd(LANE, x + (size_t)m * DM, XB + (size_t)m * DM, RSTDX + m); }
        { const float* mem = IN_(1); bf16* MEMB = WSP(bf16, WS_MEMB); float* RSTDM = WSP(float, CTL_RSTDM);
          for (int m = gw; m < NB * NMEM; m += NGW) row_to_bf16_rstd(LANE, mem + (size_t)m * DM, MEMB + (size_t)m * DM, RSTDM + m); }
        { float* SSQ1 = WSP(float, CTL_SSQ1); float* SSQ2 = WSP(float, CTL_SSQ2); for (int i = gt; i < T; i += NGT) { SSQ1[i] = 0.f; SSQ2[i] = 0.f; } }
    }
    SEAM(0);
    if (IN(1)) {
        { PHASE_KA; pg8::Gemm g{WSP(bf16, WS_XB), WSP(bf16, WS_WIN), DM, DM, DM}; pg8::StaticOrder S; S.init(T, DINP, F.G, (int)blockIdx.x, DM, DM);
          EpiRoute E{WSP(bf16, WS_PRKV), WSP(bf16, WS_PCV), WSP(bf16, WS_PG), WSP(bf16, WS_PLI), WSP(float, CTL_RSTDX)}; pg8::gemm_phase(F.lds, F.wave, g, S, E); }
        { PHASE_KA; pg8::Gemm g{WSP(bf16, WS_MEMB), WSP(bf16, WS_WKV), DM, DM, DM}; pg8::StaticOrder S; S.init(NB * NMEM, DM, F.G, (int)((blockIdx.x + 128) % F.G), DM, DM);
          EpiRowBf16<0> E{WSP(bf16, WS_KMAT), DM, 256, WSP(float, CTL_RSTDM), 1.f}; pg8::gemm_phase(F.lds, F.wave, g, S, E); }
        { PHASE_KA; pg8::Gemm g{WSP(bf16, WS_WKV) + (size_t)DM * DM, WSP(bf16, WS_MEMB), DM, DM, DM}; pg8::StaticOrder S; S.init(DM, NB * NMEM, F.G, (int)((blockIdx.x + 120) % F.G), DM, DM);
          EpiRowBf16<3> E{WSP(bf16, WS_VT), NB * NMEM, 256, WSP(float, CTL_RSTDM), 1.f}; pg8::gemm_phase(F.lds, F.wave, g, S, E); }
    }
    SEAM(1);
    if (IN(2)) {
        PHASE_IDS; PHASE_KA;
        const float* mu = IN_(5); const float* conv_w = IN_(16);
        const bf16* PLI = WSP(bf16, WS_PLI); const bf16* PCV = WSP(bf16, WS_PCV); bf16* AP = WSP(bf16, WS_AP); bf16* OUTB = WSP(bf16, WS_OUTB);
        for (int t = gw; t < T; t += NGW) {
            const bool first = (t % SEQ) == 0;
            for (int c = LANE; c < LORA_K; c += 64) { float v = 0.f;
                if (c < 288) { const float p = bf2f(PLI[(size_t)t * 288 + c]); const float pv = first ? 0.f : bf2f(PLI[(size_t)(t - 1) * 288 + c]);
                    const float s = p + (pv - p) * mu[1536 + c];
                    v = (c < 64) ? tanhf(s) : (c < 128) ? s : sigmoidf_(s); }
                AP[(size_t)t * LORA_K + c] = (bf16)f2bf(v); }
            { const int c = LANE * 8, tl = t % SEQ; const bf16* p = PCV + (size_t)t * 1536;
              f32x4 b0, b1, c0, c1, x0, x1, u0a, u0b, u1a = (f32x4){0.f, 0.f, 0.f, 0.f}, u1b = u1a, u2a = u1a, u2b = u1a;
              unpack8(*(const u32x4*)(p + c), b0, b1); unpack8(*(const u32x4*)(p + 512 + c), c0, c1); unpack8(*(const u32x4*)(p + 1024 + c), x0, x1); u0a = c0 * x0; u0b = c1 * x1;
              if (tl >= 1) { unpack8(*(const u32x4*)(p - 1536 + 512 + c), c0, c1); unpack8(*(const u32x4*)(p - 1536 + 1024 + c), x0, x1); u1a = c0 * x0; u1b = c1 * x1; }
              if (tl >= 2) { unpack8(*(const u32x4*)(p - 3072 + 512 + c), c0, c1); unpack8(*(const u32x4*)(p - 3072 + 1024 + c), x0, x1); u2a = c0 * x0; u2b = c1 * x1; }
              const f32x4 w0a = *(const f32x4*)(conv_w + c), w0b = *(const f32x4*)(conv_w + c + 4), w1a = *(const f32x4*)(conv_w + 512 + c), w1b = *(const f32x4*)(conv_w + 512 + c + 4),
                          w2a = *(const f32x4*)(conv_w + 1024 + c), w2b = *(const f32x4*)(conv_w + 1024 + c + 4);
              const f32x4 ya = b0 * (w0a * u2a + w1a * u1a + w2a * u0a), yb = b1 * (w0b * u2b + w1b * u1b + w2b * u0b);
              *(u32x4*)(OUTB + (size_t)t * DR + c) = pack8(ya, yb); }
        }
    }
    SEAM(2);
    if (IN(3)) {
        PHASE_KA; pg8::Gemm g{WSP(bf16, WS_AP), WSP(bf16, WS_LORA), LORA_K, LORA_K, LORA_K}; pg8::StaticOrder S; S.init(T, LORA_N, F.G, (int)blockIdx.x, LORA_K, LORA_K);
        EpiLora E{WSP(float, WS_LW), WSP(bf16, WS_ALR), (bf16*)ka->out, IN_(6), IN_(8)}; pg8::gemm_phase(F.lds, F.wave, g, S, E);
    }
    SEAM(3);
    if (IN(4)) {
        PHASE_KA; unsigned char* dout = (unsigned char*)ka->out;
        wkv::ChunkIn I{WSP(bf16, WS_PRKV), WSP(float, WS_LW), WSP(bf16, WS_ALR), IN_(5), IN_(11), IN_(12), IN_(13), WSP(float, CTL_BON),
                       (bf16*)(dout + DO_R2), (bf16*)(dout + DO_Y2), (bf16*)(dout + DO_AG), (bf16*)(dout + DO_BG)};
        for (int grp = blockIdx.x; grp < NB * NH * NGRP; grp += F.G) wkv::group_phase(F.lds, F.wave, grp, I);
    }
    SEAM(4);
    if (IN(5)) {
        if ((int)blockIdx.x < NB * NH && F.wave < 2) { PHASE_KA; unsigned char* dout = (unsigned char*)ka->out;
            wkv::chain_phase((int)blockIdx.x, F.wave, (const bf16*)(dout + DO_AG), (const bf16*)(dout + DO_BG), (bf16*)(dout + DO_XG)); }
    }
    SEAM(5);
    if (IN(6)) {
        PHASE_KA; unsigned char* dout = (unsigned char*)ka->out;
        wkv::OutIn I{(const bf16*)(dout + DO_R2), (const bf16*)(dout + DO_Y2), (const bf16*)(dout + DO_XG), WSP(bf16, WS_PRKV), IN_(5), WSP(float, CTL_BON), (const bf16*)dout, IN_(14), IN_(15), WSP(bf16, WS_OUTA)};
        for (int task = gw; task < NB * NH * NCH * 4; task += NGW) wkv::out_task(task, I);
    }
    SEAM(6);
    if (IN(7)) {
        { PHASE_KA; pg8::Gemm g{WSP(bf16, WS_OUTA), WSP(bf16, WS_WPA), DR, DR, DR}; pg8::StaticOrder S; S.init(T, DM, F.G, (int)blockIdx.x, DR, DR);
          EpiGate<0> E{WSP(bf16, WS_PG), 0, IN_(4), WSP(float, WS_MA), WSP(bf16, WS_MERGED)}; pg8::gemm_phase(F.lds, F.wave, g, S, E); }
        { PHASE_KA; pg8::Gemm g{WSP(bf16, WS_OUTB), WSP(bf16, WS_WPB), DR, DR, DR}; pg8::StaticOrder S; S.init(T, DM, F.G, (int)blockIdx.x, DR, DR);
          EpiGate<1> E{WSP(bf16, WS_PG), 1024, IN_(4) + DM, WSP(float, WS_MA), WSP(bf16, WS_MERGED)}; pg8::gemm_phase(F.lds, F.wave, g, S, E); }
    }
    SEAM(7);
    if (IN(8)) {
        PHASE_KA; pg8::Gemm g{WSP(bf16, WS_MERGED), WSP(bf16, WS_WOUT), DM, DM, DM}; pg8::StaticOrder S; S.init(T, DM, F.G, (int)blockIdx.x, DM, DM);
        EpiResid<1> E{IN_(0), ka->out, WSP(bf16, WS_XB1), WSP(float, CTL_SSQ1)}; pg8::gemm_phase(F.lds, F.wave, g, S, E);
    }
    SEAM(8);
    if (IN(9)) {
        PHASE_KA; pg8::Gemm g{WSP(bf16, WS_XB1), WSP(bf16, WS_WQ), DM, DM, DM}; pg8::StaticOrder S; S.init(T, DM, F.G, (int)blockIdx.x, DM, DM);
        EpiRowBf16<1> E{WSP(bf16, WS_Q), DM, 256, WSP(float, CTL_SSQ1), 0.0625f * 1.4426950408889634f}; pg8::gemm_phase(F.lds, F.wave, g, S, E);
    }
    SEAM(9);
    if (IN(10)) {
        PHASE_KA; pg8::Gemm g{WSP(bf16, WS_Q), WSP(bf16, WS_KMAT), DM, DM, XD}; pg8::AttnOrder S{F.G, (int)blockIdx.x, (unsigned)NMEM * DM * 2, (unsigned)XD * 2};
        EpiSoftmax E{WSP(bf16, WS_P)}; pg8::gemm_phase(F.lds, F.wave, g, S, E);
    }
    SEAM(10);
    if (IN(11)) {
        PHASE_KA; pg8::Gemm g{WSP(bf16, WS_P), WSP(bf16, WS_VT), DM, NB * NMEM, NMEM}; pg8::AttnOrder S{F.G, (int)blockIdx.x, (unsigned)NMEM * 2, (unsigned)XD * NB * NMEM * 2};
        EpiRowBf16<4> E{WSP(bf16, WS_O), DM, 256, nullptr, 1.f}; pg8::gemm_phase(F.lds, F.wave, g, S, E);
    }
    SEAM(11);
    if (IN(12)) {
        PHASE_KA; pg8::Gemm g{WSP(bf16, WS_O), WSP(bf16, WS_WXO), DM, DM, DM}; pg8::StaticOrder S; S.init(T, DM, F.G, (int)blockIdx.x, DM, DM);
        EpiResid<1> E{ka->out, ka->out, WSP(bf16, WS_XB2), WSP(float, CTL_SSQ2)}; pg8::gemm_phase(F.lds, F.wave, g, S, E);
    }
    SEAM(12);
    if (IN(13)) {
        PHASE_KA; pg8::Gemm g{WSP(bf16, WS_XB2), WSP(bf16, WS_WUP), DM, DM, DM}; pg8::StaticOrder S; S.init(T, DFF, F.G, (int)blockIdx.x, DM, DM);
        EpiRowBf16<2> E{WSP(bf16, WS_HID), DFF, 256, WSP(float, CTL_SSQ2), 1.f}; pg8::gemm_phase(F.lds, F.wave, g, S, E);
    }
    SEAM(13);
    if (IN(14)) {
        PHASE_KA; pg8::Gemm g{WSP(bf16, WS_HID), WSP(bf16, WS_WDN), DFF, DFF, DFF}; pg8::StaticOrder S; S.init(T, DM, F.G, (int)blockIdx.x, DFF, DFF);
        EpiResid<0> E{ka->out, ka->out, nullptr, nullptr}; pg8::gemm_phase(F.lds, F.wave, g, S, E);
    }
    SEAM(14);
    if (IN(15)) {
        PHASE_IDS; PHASE_KA; float* out = ka->out; const float* norm_final = IN_(28);
        for (int m = gw; m < T; m += NGW) {
            GAS f32x4* xr = (GAS f32x4*)(out + (size_t)m * DM) + LANE; f32x4 v[4]; float s = 0.f;
#pragma unroll
            for (int j = 0; j < 4; ++j) { v[j] = xr[64 * j]; s += (v[j].x * v[j].x + v[j].y * v[j].y) + (v[j].z * v[j].z + v[j].w * v[j].w); }
            const float r = rsqrtf(wave_sum(s) * (1.f / DM) + RMS_EPS);
#pragma unroll
            for (int j = 0; j < 4; ++j) xr[64 * j] = v[j] * r * ((const f32x4*)norm_final)[LANE + 64 * j];
        }
    }
#undef IN
#undef SEAM
}
#ifndef MK_N_LAUNCHES
#define MK_N_LAUNCHES 1
#endif
extern "C" void kernel_launch(void* const* d_in, const int* in_sizes, int n_in, void* d_out, int out_size, void* d_ws, size_t ws_size, hipStream_t stream) {
    static int grid = 0;
    if (grid == 0) {
        if (n_in != 29 || in_sizes[0] != T * DM || out_size != T * DM || ws_size < WS_END) { fprintf(stderr, "kernel_launch: unexpected shapes (n_in %d, ws %zu)\n", n_in, ws_size); grid = -1; return; }
        int dev = 0, cus = 0, per_cu = 0;
        if (hipGetDevice(&dev) != hipSuccess || hipDeviceGetAttribute(&cus, hipDeviceAttributeMultiprocessorCount, dev) != hipSuccess) { grid = -1; return; }
        if (hipFuncSetAttribute((const void*)mk_fwd, hipFuncAttributeMaxDynamicSharedMemorySize, LDS_BYTES) != hipSuccess) { fprintf(stderr, "kernel_launch: hipFuncSetAttribute failed\n"); grid = -1; return; }
        if (hipOccupancyMaxActiveBlocksPerMultiprocessor(&per_cu, (const void*)mk_fwd, NWAVES * 64, LDS_BYTES) != hipSuccess || per_cu < 1) fprintf(stderr, "kernel_launch: occupancy query reports %d\n", per_cu);
        (void)hipGetLastError();
        grid = cus;
        if (grid != 256) fprintf(stderr, "kernel_launch: note: %d CUs\n", grid);
    }
    if (grid < 0) return;
    if (hipMemsetAsync((char*)d_ws + WS_CTL, 0, 64 * 1024, stream) != hipSuccess) { fprintf(stderr, "kernel_launch: memset failed\n"); return; }
    Args a{};
    for (int i = 0; i < 29; ++i) a.in[i] = (const float*)d_in[i];
    a.out = (float*)d_out; a.ws = (unsigned char*)d_ws;
    if (MK_N_LAUNCHES == 1) { a.ph_lo = 0; a.ph_hi = N_PHASES; hipLaunchKernelGGL(mk_fwd, dim3(grid), dim3(NWAVES * 64), LDS_BYTES, stream, a); }
    else for (int p = 0; p < N_PHASES; ++p) { a.ph_lo = p; a.ph_hi = p + 1; hipLaunchKernelGGL(mk_fwd, dim3(grid), dim3(NWAVES * 64), LDS_BYTES, stream, a); }
}
```
